# Optimizing an MI355X kernel written in HIP

```python
import math
import jax
import jax.numpy as jnp
from jax import lax
import numpy as np

D_MODEL = 1024
BATCH = 8
SEQ = 2048
DEPTH = 4

GRID_W = 64
CTX_LEN = 256
N_MIXERS = 3
EPS = 1e-6

CHUNK = 128
SG_WIDTH = D_MODEL
SG_GROUPS = 8
SG_GROUP_DIM = SG_WIDTH // SG_GROUPS

S5_GROUP_CH = 16
S5_WIDTH = D_MODEL
S5_GROUPS = S5_WIDTH // S5_GROUP_CH
S5_STATE = 64
S5_DT_MIN = 1e-3
S5_DT_MAX = 1e-1

MLA_HEADS = 8
MLA_NOPE = 128
MLA_ROPE = 64
MLA_QK = MLA_NOPE + MLA_ROPE
MLA_V = 128
MLA_Q_RANK = 384
MLA_KV_RANK = 256
ROPE_THETA = 10000.0
Q_BLOCK = 128

N_EXPERTS = 32
TOP_K = 4
D_EXPERT = D_MODEL
SWIGLU_LIMIT = 7.0
SWIGLU_ALPHA = 1.702
MOE_BLOCK = 256

kernel_name = 'hybrid_gmlp_s5_mla_moe_diffusion'


def rmsnorm(x, g):
    xf = x.astype(jnp.float32)
    y = xf * lax.rsqrt(jnp.mean(xf * xf, axis=-1, keepdims=True) + EPS)
    return (y * g.astype(jnp.float32)).astype(x.dtype)


def adaln(h, g, shift, scale):
    return rmsnorm(h, g) * (1 + scale) + shift


def chunk_gmlp(h, w_in, g_v, w_s, b_s, w_out):
    bsz, length, _ = h.shape
    u, v = jnp.split(jax.nn.gelu(h @ w_in, approximate=False), 2, axis=-1)
    v = rmsnorm(v, g_v).reshape(bsz, length // CHUNK, CHUNK, SG_GROUPS, SG_GROUP_DIM)
    sv = jnp.einsum('gpq,bnqgc->bnpgc', w_s, v) + b_s.T[None, None, :, :, None]
    return (u * sv.reshape(bsz, length, SG_WIDTH)) @ w_out


def s5_discretize(lam_re, lam_im, log_dt, b_re, b_im):
    f32 = jnp.float32
    lam_re = lam_re.astype(f32)
    lam_im = lam_im.astype(f32)
    b_re = b_re.astype(f32)
    b_im = b_im.astype(f32)
    dt = jnp.exp(log_dt.astype(f32))[:, None]
    mag = jnp.exp(lam_re * dt)
    a_re = mag * jnp.cos(lam_im * dt)
    a_im = mag * jnp.sin(lam_im * dt)
    den = lam_re * lam_re + lam_im * lam_im
    n_re = a_re - 1.0
    f_re = (n_re * lam_re + a_im * lam_im) / den
    f_im = (a_im * lam_re - n_re * lam_im) / den
    bb_re = f_re[..., None] * b_re - f_im[..., None] * b_im
    bb_im = f_re[..., None] * b_im + f_im[..., None] * b_re
    return a_re, a_im, bb_re, bb_im


def _ssm_combine(left, right):
    a1r, a1i, b1r, b1i = left
    a2r, a2i, b2r, b2i = right
    return (a2r * a1r - a2i * a1i, a2r * a1i + a2i * a1r,
            a2r * b1r - a2i * b1i + b2r, a2r * b1i + a2i * b1r + b2i)


def s5_scan(xs, a_re, a_im, bb_re, bb_im, h0_re, h0_im, reverse):
    u_re = jnp.einsum('blgc,gpc->blgp', xs, bb_re)
    u_im = jnp.einsum('blgc,gpc->blgp', xs, bb_im)
    first = -1 if reverse else 0
    u_re = u_re.at[:, first].add(a_re * h0_re - a_im * h0_im)
    u_im = u_im.at[:, first].add(a_re * h0_im + a_im * h0_re)
    ar = jnp.broadcast_to(a_re, u_re.shape)
    ai = jnp.broadcast_to(a_im, u_re.shape)
    _, _, h_re, h_im = lax.associative_scan(_ssm_combine, (ar, ai, u_re, u_im), axis=1, reverse=reverse)
    return h_re, h_im


def s5_readout(h_re, h_im, c_re, c_im):
    return jnp.einsum('blgp,gcp->blgc', h_re, c_re) - jnp.einsum('blgp,gcp->blgc', h_im, c_im)


def s5_mixer(n_lat, n_ctx, w_in, lam_re, lam_im, log_dt, b_re, b_im, c_re, c_im, d_skip, w_glu, ctx_out):
    f32 = jnp.float32
    bsz, length, _ = n_lat.shape
    xs_l = (n_lat @ w_in).astype(f32).reshape(bsz, length, S5_GROUPS, S5_GROUP_CH)
    xs_c = (n_ctx @ w_in).astype(f32).reshape(bsz, n_ctx.shape[1], S5_GROUPS, S5_GROUP_CH)
    d = d_skip.astype(f32).reshape(S5_GROUPS, S5_GROUP_CH)
    y_l = d * xs_l
    y_c = d * xs_c if ctx_out else None
    h0 = jnp.zeros((bsz, S5_GROUPS, S5_STATE), f32)
    for direction, rev in enumerate((False, True)):
        a_re, a_im, bb_re, bb_im = s5_discretize(lam_re[direction], lam_im[direction], log_dt[direction],
                                                 b_re[direction], b_im[direction])
        cr = c_re[direction].astype(f32)
        ci = c_im[direction].astype(f32)
        hc_re, hc_im = s5_scan(xs_c, a_re, a_im, bb_re, bb_im, h0, h0, rev)
        end = 0 if rev else -1
        hl_re, hl_im = s5_scan(xs_l, a_re, a_im, bb_re, bb_im, hc_re[:, end], hc_im[:, end], rev)
        y_l = y_l + s5_readout(hl_re, hl_im, cr, ci)
        if ctx_out:
            y_c = y_c + s5_readout(hc_re, hc_im, cr, ci)

    def glu_out(y):
        y = jax.nn.gelu(y.reshape(y.shape[0], y.shape[1], S5_WIDTH).astype(n_lat.dtype), approximate=False)
        z1, z2 = jnp.split(y @ w_glu, 2, axis=-1)
        return z1 * jax.nn.sigmoid(z2)

    return glu_out(y_l), (glu_out(y_c) if ctx_out else None)


def axial_rope(x):
    length = x.shape[1]
    rows = length // GRID_W
    row = jnp.repeat(jnp.arange(rows), GRID_W).astype(jnp.float32)
    col = jnp.tile(jnp.arange(GRID_W), rows).astype(jnp.float32)
    quarter = MLA_ROPE // 4
    inv_freq = ROPE_THETA ** (-jnp.arange(quarter, dtype=jnp.float32) / quarter)
    ang = jnp.stack([row[:, None] * inv_freq, col[:, None] * inv_freq], axis=1)
    cos = jnp.cos(ang)[None, :, None]
    sin = jnp.sin(ang)[None, :, None]
    xr = x.astype(jnp.float32).reshape(x.shape[:-1] + (2, 2, quarter))
    x1 = xr[..., 0, :]
    x2 = xr[..., 1, :]
    out = jnp.stack([x1 * cos - x2 * sin, x2 * cos + x1 * sin], axis=-2)
    return out.reshape(x.shape).astype(x.dtype)


def block_attention(q, k, v):
    bsz, nh, lq, dk = q.shape
    scale = 1.0 / math.sqrt(dk)
    qb = q.reshape(bsz, nh, lq // Q_BLOCK, Q_BLOCK, dk).transpose(2, 0, 1, 3, 4)

    def one_block(qblk):
        s = jnp.einsum('bhqd,bhkd->bhqk', qblk, k).astype(jnp.float32) * scale
        p = jax.nn.softmax(s, axis=-1).astype(v.dtype)
        return jnp.einsum('bhqk,bhkd->bhqd', p, v)

    o = lax.map(one_block, qb)
    return o.transpose(1, 2, 0, 3, 4).reshape(bsz, nh, lq, v.shape[-1])


def mla_mixer(n_lat, n_ctx, w_in, g_q, g_kv, w_uq, w_ukv, g_qn, g_kn, w_out, ctx_out):
    def project(h, rotate):
        bsz, length, _ = h.shape
        z = h @ w_in
        q_lat = z[..., :MLA_Q_RANK]
        kv_lat = z[..., MLA_Q_RANK:MLA_Q_RANK + MLA_KV_RANK]
        k_pe = z[..., MLA_Q_RANK + MLA_KV_RANK:]
        q = (rmsnorm(q_lat, g_q) @ w_uq).reshape(bsz, length, MLA_HEADS, MLA_QK)
        kv = (rmsnorm(kv_lat, g_kv) @ w_ukv).reshape(bsz, length, MLA_HEADS, MLA_NOPE + MLA_V)
        k = jnp.concatenate([kv[..., :MLA_NOPE],
                             jnp.broadcast_to(k_pe[:, :, None, :], (bsz, length, MLA_HEADS, MLA_ROPE))], axis=-1)
        v = kv[..., MLA_NOPE:]
        q = rmsnorm(q, g_qn)
        k = rmsnorm(k, g_kn)
        if rotate:
            q = jnp.concatenate([q[..., :MLA_NOPE], axial_rope(q[..., MLA_NOPE:])], axis=-1)
            k = jnp.concatenate([k[..., :MLA_NOPE], axial_rope(k[..., MLA_NOPE:])], axis=-1)
        return q.transpose(0, 2, 1, 3), k.transpose(0, 2, 1, 3), v.transpose(0, 2, 1, 3)

    def merge(o):
        bsz, nh, length, dv = o.shape
        return o.transpose(0, 2, 1, 3).reshape(bsz, length, nh * dv) @ w_out

    q_c, k_c, v_c = project(n_ctx, False)
    q_l, k_l, v_l = project(n_lat, True)
    o_l = block_attention(q_l, jnp.concatenate([k_c, k_l], axis=2), jnp.concatenate([v_c, v_l], axis=2))
    o_c = merge(block_attention(q_c, k_c, v_c)) if ctx_out else None
    return merge(o_l), o_c


def moe_ffn(h, w_router, b_router, w_gate, b_gate, w_up, b_up, w_down, b_down):
    n_tok, d = h.shape
    logits = (h @ w_router).astype(jnp.float32) + b_router.astype(jnp.float32)
    top_val, top_idx = lax.top_k(logits, TOP_K)
    gates = jax.nn.softmax(top_val, axis=-1)
    n_assign = n_tok * TOP_K
    flat_e = top_idx.reshape(-1)
    order = jnp.argsort(flat_e)
    sorted_e = flat_e[order]
    sorted_tok = (order // TOP_K).astype(jnp.int32)
    sorted_gate = gates.reshape(-1)[order]
    counts = jnp.bincount(flat_e, length=N_EXPERTS)
    padded = (counts + MOE_BLOCK - 1) // MOE_BLOCK * MOE_BLOCK
    pad_end = jnp.cumsum(padded)
    pad_start = pad_end - padded
    start = jnp.cumsum(counts) - counts
    dest = pad_start[sorted_e] + jnp.arange(n_assign) - start[sorted_e]
    n_blocks = -(-n_assign // MOE_BLOCK) + N_EXPERTS
    buf = n_blocks * MOE_BLOCK
    tok_buf = jnp.full((buf,), n_tok, jnp.int32).at[dest].set(sorted_tok)
    gate_buf = jnp.zeros((buf,), jnp.float32).at[dest].set(sorted_gate)
    blk_expert = jnp.minimum(jnp.searchsorted(pad_end, jnp.arange(n_blocks) * MOE_BLOCK, side='right'),
                             N_EXPERTS - 1)
    h_pad = jnp.concatenate([h, jnp.zeros((1, d), h.dtype)], axis=0)
    xb = h_pad[tok_buf].reshape(n_blocks, MOE_BLOCK, d)

    def expert_block(args):
        xblk, e = args
        g = jnp.minimum(xblk @ w_gate[e] + b_gate[e], SWIGLU_LIMIT)
        u = jnp.clip(xblk @ w_up[e] + b_up[e], -SWIGLU_LIMIT, SWIGLU_LIMIT)
        a = g * jax.nn.sigmoid(SWIGLU_ALPHA * g) * (u + 1)
        return a @ w_down[e] + b_down[e]

    yb = lax.map(expert_block, (xb, blk_expert)).reshape(buf, d)
    yb = yb * gate_buf[:, None].astype(yb.dtype)
    out = jnp.zeros((n_tok + 1, d), yb.dtype).at[tok_buf].add(yb)
    return out[:n_tok]


def setup_inputs(seed: int = 0) -> dict:
    f32 = jnp.float32
    key = jax.random.key(seed)
    ks = list(jax.random.split(key, 48))

    def nrm(shape, scale):
        return jax.random.normal(ks.pop(), shape, f32) * scale

    def gain(shape):
        return 1.0 + nrm(shape, 0.02)

    n_a = len(range(0, DEPTH, N_MIXERS))
    n_b = len(range(1, DEPTH, N_MIXERS))
    n_c = len(range(2, DEPTH, N_MIXERS))
    return {
        'x': nrm((BATCH, SEQ, D_MODEL), 1.0),
        'c': nrm((BATCH, D_MODEL), 1.0),
        'ctx': nrm((BATCH, CTX_LEN, D_MODEL), 1.0),
        'c_ctx': nrm((D_MODEL,), 1.0),
        'w_ada': nrm((DEPTH, D_MODEL, 6 * D_MODEL), 0.5 * D_MODEL ** -0.5),
        'b_ada': nrm((DEPTH, 6 * D_MODEL), 0.02),
        'g_norm1': gain((DEPTH, D_MODEL)),
        'g_norm2': gain((DEPTH, D_MODEL)),
        'sg_w_in': nrm((n_a, D_MODEL, 2 * SG_WIDTH), D_MODEL ** -0.5),
        'sg_g_v': gain((n_a, SG_WIDTH)),
        'sg_w_s': nrm((n_a, SG_GROUPS, CHUNK, CHUNK), CHUNK ** -0.5),
        'sg_b_s': gain((n_a, SG_GROUPS, CHUNK)),
        'sg_w_out': nrm((n_a, SG_WIDTH, D_MODEL), SG_WIDTH ** -0.5),
        'ssm_w_in': nrm((n_b, D_MODEL, S5_WIDTH), D_MODEL ** -0.5),
        'ssm_lam_re': -0.5 + nrm((n_b, 2, S5_GROUPS, S5_STATE), 0.01),
        'ssm_lam_im': jnp.pi * jnp.arange(S5_STATE, dtype=f32) + nrm((n_b, 2, S5_GROUPS, S5_STATE), 0.01),
        'ssm_log_dt': jax.random.uniform(ks.pop(), (n_b, 2, S5_GROUPS), f32,
                                         math.log(S5_DT_MIN), math.log(S5_DT_MAX)),
        'ssm_b_re': nrm((n_b, 2, S5_GROUPS, S5_STATE, S5_GROUP_CH), (2 * S5_GROUP_CH) ** -0.5),
        'ssm_b_im': nrm((n_b, 2, S5_GROUPS, S5_STATE, S5_GROUP_CH), (2 * S5_GROUP_CH) ** -0.5),
        'ssm_c_re': nrm((n_b, 2, S5_GROUPS, S5_GROUP_CH, S5_STATE), S5_STATE ** -0.5),
        'ssm_c_im': nrm((n_b, 2, S5_GROUPS, S5_GROUP_CH, S5_STATE), S5_STATE ** -0.5),
        'ssm_d': nrm((n_b, S5_WIDTH), 1.0),
        'ssm_w_glu': nrm((n_b, S5_WIDTH, 2 * D_MODEL), S5_WIDTH ** -0.5),
        'mla_w_in': nrm((n_c, D_MODEL, MLA_Q_RANK + MLA_KV_RANK + MLA_ROPE), D_MODEL ** -0.5),
        'mla_g_q': gain((n_c, MLA_Q_RANK)),
        'mla_g_kv': gain((n_c, MLA_KV_RANK)),
        'mla_w_uq': nrm((n_c, MLA_Q_RANK, MLA_HEADS * MLA_QK), MLA_Q_RANK ** -0.5),
        'mla_w_ukv': nrm((n_c, MLA_KV_RANK, MLA_HEADS * (MLA_NOPE + MLA_V)), MLA_KV_RANK ** -0.5),
        'mla_g_qn': gain((n_c, MLA_QK)),
        'mla_g_kn': gain((n_c, MLA_QK)),
        'mla_w_out': nrm((n_c, MLA_HEADS * MLA_V, D_MODEL), (MLA_HEADS * MLA_V) ** -0.5),
        'moe_w_router': nrm((DEPTH, D_MODEL, N_EXPERTS), D_MODEL ** -0.5),
        'moe_b_router': nrm((DEPTH, N_EXPERTS), 0.01),
        'moe_w_gate': nrm((DEPTH, N_EXPERTS, D_MODEL, D_EXPERT), D_MODEL ** -0.5),
        'moe_b_gate': nrm((DEPTH, N_EXPERTS, D_EXPERT), 0.01),
        'moe_w_up': nrm((DEPTH, N_EXPERTS, D_MODEL, D_EXPERT), D_MODEL ** -0.5),
        'moe_b_up': nrm((DEPTH, N_EXPERTS, D_EXPERT), 0.01),
        'moe_w_down': nrm((DEPTH, N_EXPERTS, D_EXPERT, D_MODEL), D_EXPERT ** -0.5),
        'moe_b_down': nrm((DEPTH, N_EXPERTS, D_MODEL), 0.01),
    }


def reference(x, c, ctx, c_ctx, w_ada, b_ada, g_norm1, g_norm2,
              sg_w_in, sg_g_v, sg_w_s, sg_b_s, sg_w_out,
              ssm_w_in, ssm_lam_re, ssm_lam_im, ssm_log_dt, ssm_b_re, ssm_b_im, ssm_c_re, ssm_c_im,
              ssm_d, ssm_w_glu,
              mla_w_in, mla_g_q, mla_g_kv, mla_w_uq, mla_w_ukv, mla_g_qn, mla_g_kn, mla_w_out,
              moe_w_router, moe_b_router, moe_w_gate, moe_b_gate, moe_w_up, moe_b_up, moe_w_down, moe_b_down):
    h_lat, h_ctx = x, ctx
    s_lat = jax.nn.silu(c)
    s_ctx = jax.nn.silu(c_ctx)
    for i in range(DEPTH):
        mixer, slot = i % N_MIXERS, i // N_MIXERS
        ctx_out = i < DEPTH - 1
        ctx_in = ctx_out or mixer != 0
        mod_l = jnp.split((s_lat @ w_ada[i] + b_ada[i])[:, None, :], 6, axis=-1)
        mod_c = jnp.split(s_ctx @ w_ada[i] + b_ada[i], 6, axis=-1)
        n_lat = adaln(h_lat, g_norm1[i], mod_l[0], mod_l[1])
        n_ctx = adaln(h_ctx, g_norm1[i], mod_c[0], mod_c[1]) if ctx_in else None
        if mixer == 0:
            m_lat = chunk_gmlp(n_lat, sg_w_in[slot], sg_g_v[slot], sg_w_s[slot], sg_b_s[slot], sg_w_out[slot])
            m_ctx = (chunk_gmlp(n_ctx, sg_w_in[slot], sg_g_v[slot], sg_w_s[slot], sg_b_s[slot], sg_w_out[slot])
                     if ctx_out else None)
        elif mixer == 1:
            m_lat, m_ctx = s5_mixer(n_lat, n_ctx, ssm_w_in[slot], ssm_lam_re[slot], ssm_lam_im[slot],
                                    ssm_log_dt[slot], ssm_b_re[slot], ssm_b_im[slot], ssm_c_re[slot],
                                    ssm_c_im[slot], ssm_d[slot], ssm_w_glu[slot], ctx_out)
        else:
            m_lat, m_ctx = mla_mixer(n_lat, n_ctx, mla_w_in[slot], mla_g_q[slot], mla_g_kv[slot],
                                     mla_w_uq[slot], mla_w_ukv[slot], mla_g_qn[slot], mla_g_kn[slot],
                                     mla_w_out[slot], ctx_out)
        h_lat = h_lat + mod_l[2] * m_lat
        n_lat = adaln(h_lat, g_norm2[i], mod_l[3], mod_l[4])
        moe_args = (moe_w_router[i], moe_b_router[i], moe_w_gate[i], moe_b_gate[i],
                    moe_w_up[i], moe_b_up[i], moe_w_down[i], moe_b_down[i])
        if ctx_out:
            h_ctx = h_ctx + mod_c[2] * m_ctx
            n_ctx = adaln(h_ctx, g_norm2[i], mod_c[3], mod_c[4])
            n_l = n_lat.shape[0] * n_lat.shape[1]
            f = moe_ffn(jnp.concatenate([n_lat.reshape(-1, D_MODEL), n_ctx.reshape(-1, D_MODEL)], axis=0),
                        *moe_args)
            h_lat = h_lat + mod_l[5] * f[:n_l].reshape(h_lat.shape)
            h_ctx = h_ctx + mod_c[5] * f[n_l:].reshape(h_ctx.shape)
        else:
            h_lat = h_lat + mod_l[5] * moe_ffn(n_lat.reshape(-1, D_MODEL), *moe_args).reshape(h_lat.shape)
    return h_lat
```

```cpp
#include <hip/hip_runtime.h>
#include <cstdio>
#include <cstdint>
#include <cmath>

#define LAS __attribute__((address_space(3)))
#define GAS __attribute__((address_space(1)))
typedef unsigned short bf16;
typedef short bf16x8 __attribute__((ext_vector_type(8)));
typedef short s16x4 __attribute__((ext_vector_type(4)));
typedef float f32x4 __attribute__((ext_vector_type(4)));
typedef float f32x2 __attribute__((ext_vector_type(2)));
typedef float f32x16 __attribute__((ext_vector_type(16)));
typedef unsigned u32x4 __attribute__((ext_vector_type(4)));
typedef unsigned u32x2 __attribute__((ext_vector_type(2)));

constexpr int D = 1024, NB = 8, SEQ = 2048, CTXL = 256, DEPTH = 4;
constexpr int TL = NB * SEQ, TC = NB * CTXL, TT = TL + TC;
constexpr int NE = 32, TOPK = 4;
constexpr float EPS = 1e-6f;
constexpr int KEYS = CTXL + SEQ;
constexpr int DQK = 192, DV = 128, NH = 8;
constexpr int S5G = 64, S5ROWS = 1152, S5PAD = 1280;
constexpr int NWAVES = 8, NTHREADS = 512;

constexpr size_t MiB = 1u << 20;
constexpr size_t WS_CTL = 0, CTL_ZERO_BYTES = 1 * MiB;
constexpr size_t WS_MOD = 1 * MiB;
constexpr size_t WS_WSGIN = 2 * MiB;
constexpr size_t WS_WSGOUT = 10 * MiB;
constexpr size_t WS_WSSMIN = 14 * MiB;
constexpr size_t WS_WGLU = 16 * MiB;
constexpr size_t WS_WMLAIN = 20 * MiB;
constexpr size_t WS_WUQ = 22 * MiB;
constexpr size_t WS_WUKV = 24 * MiB;
constexpr size_t WS_WMLAOUT = 26 * MiB;
constexpr size_t WS_GT = 28 * MiB;
constexpr size_t WS_TET = 36 * MiB;
constexpr size_t WS_A16 = 52 * MiB;
constexpr size_t WS_SMALL = 53 * MiB;
constexpr size_t WS_TOPE = WS_SMALL;
constexpr size_t WS_TOPG = WS_TOPE + (size_t)TT * 16;
constexpr size_t WS_TOKSLOT = WS_TOPG + (size_t)TT * 16;
constexpr size_t WS_SLOTTOK = WS_TOKSLOT + (size_t)TT * 16;
constexpr size_t WS_SLOTGATE = WS_SLOTTOK + (size_t)74752 * 4;
constexpr size_t WS_VSSQ = WS_SLOTGATE + (size_t)74752 * 4;
constexpr size_t WS_MLASSQ = WS_VSSQ + (size_t)8 * TT * 4;
constexpr size_t WS_SMALL_END = WS_MLASSQ + (size_t)TT * 24 * 4;
static_assert(WS_SMALL_END <= 64 * MiB, "small arrays");
constexpr size_t WS_H = 64 * MiB;
constexpr size_t WS_NB = 136 * MiB;
constexpr size_t WS_UB = 172 * MiB;
constexpr size_t WS_VT = 208 * MiB;
constexpr size_t WS_ZB = 244 * MiB;
constexpr size_t WS_XH = 280 * MiB;
constexpr size_t WS_SB = 360 * MiB;
constexpr size_t WS_ZL = 440 * MiB;
constexpr size_t WS_QR = 468 * MiB;
constexpr size_t WS_QF = 522 * MiB;
constexpr size_t WS_KF = 576 * MiB;
constexpr size_t WS_VF = 630 * MiB;
constexpr size_t WS_ACT = 666 * MiB;
constexpr size_t WS_YB = 812 * MiB;
constexpr size_t WS_WGU = 960 * MiB;
constexpr size_t WS_WD = 1472 * MiB;
constexpr size_t WS_END = 1728 * MiB;
constexpr int CW_TMO = 0, CW_CODE = 1;
constexpr int CW_BAR = 4096;
constexpr int CW_HIST = 147456;
constexpr int CW_MOE = 196608;
static_assert((CW_MOE + 4 * 128) * 4 <= (int)CTL_ZERO_BYTES, "ctl");

constexpr int RING_BYTES = 131072;
constexpr int MISC_OFF = RING_BYTES;
constexpr int LDS_BYTES = 147456;
constexpr int MI_BAR = 0, MI_TSTART = 64, MI_ECNT = 256, MI_ESTART = 384, MI_HIST = 512, MI_SCR = 1024;

#define RLX_AGENT __ATOMIC_RELAXED, __HIP_MEMORY_SCOPE_AGENT
#define LDS_WAIT() asm volatile("s_waitcnt lgkmcnt(0)" ::: "memory")
#define VM_WAIT() asm volatile("s_waitcnt vmcnt(0)" ::: "memory")
__device__ __forceinline__ unsigned f2bf(float f) { unsigned u = __builtin_bit_cast(unsigned, f); return (u + 0x7fffu + ((u >> 16) & 1u)) >> 16; }
__device__ __forceinline__ unsigned pk2(float lo, float hi) { return f2bf(lo) | (f2bf(hi) << 16); }
__device__ __forceinline__ float bf2f(unsigned h) { return __builtin_bit_cast(float, h << 16); }
__device__ __forceinline__ unsigned cvt_pk_bf16(float lo, float hi) { unsigned r; asm volatile("v_cvt_pk_bf16_f32 %0, %1, %2" : "=v"(r) : "v"(lo), "v"(hi)); return r; }
__device__ __forceinline__ float wave_sum(float v) {
#pragma unroll
    for (int o = 1; o < 64; o <<= 1) v += __shfl_xor(v, o);
    return v;
}
__device__ __forceinline__ float wave_max(float v) {
#pragma unroll
    for (int o = 1; o < 64; o <<= 1) v = fmaxf(v, __shfl_xor(v, o));
    return v;
}
__device__ __forceinline__ f32x2 gelu_pk(f32x2 v) {
    const f32x2 av = __builtin_elementwise_abs(v), d = av * 0.2316418882f + 1.0f;
    f32x2 t; t.x = __builtin_amdgcn_rcpf(d.x); t.y = __builtin_amdgcn_rcpf(d.y);
    f32x2 q = t * 0.5307027145f + (-0.7265760135f); q = q * t + 0.7107068705f; q = q * t + (-0.142248368f); q = q * t + 0.127414796f; q = q * t;
    const f32x2 s = (v * v) * (-0.72134752044f);
    f32x2 e; e.x = __builtin_amdgcn_exp2f(s.x); e.y = __builtin_amdgcn_exp2f(s.y);
    const f32x2 m = v * (q * e), r = v - m;
    f32x2 o; o.x = v.x < 0.f ? m.x : r.x; o.y = v.y < 0.f ? m.y : r.y; return o;
}
__device__ __forceinline__ f32x4 gelu4(f32x4 v) { f32x2 a = gelu_pk((f32x2){v[0], v[1]}), b = gelu_pk((f32x2){v[2], v[3]}); return (f32x4){a.x, a.y, b.x, b.y}; }
__device__ __forceinline__ float sigmoidf_(float x) { return __builtin_amdgcn_rcpf(1.0f + __builtin_amdgcn_exp2f(-1.4426950408889634f * x)); }

#define XB_TMO      128
#define XB_XCNT(j)  (256  + 64 * (j))
#define XB_XSUB(j)  (1280 + 64 * (j))
#define XB_XGEN(j)  (2304 + 64 * (j))
#define XB_TOP      3328
#define XB_TOPGEN   3392
#define XCD_BAR_WORDS 3456
#define XB_SPIN_CAP (1u << 18)
__device__ __forceinline__ unsigned xb_ld(unsigned* p)              { return __hip_atomic_load(p, __ATOMIC_RELAXED, __HIP_MEMORY_SCOPE_AGENT); }
__device__ __forceinline__ unsigned xb_add(unsigned* p, unsigned v) { return __hip_atomic_fetch_add(p, v, __ATOMIC_RELAXED, __HIP_MEMORY_SCOPE_AGENT); }
__device__ __forceinline__ unsigned xb_xcc_id() { return (unsigned)__builtin_amdgcn_s_getreg((3 << 11) | 20) & 0xFu; }
#define XB_SPIN(cond, bar) do { unsigned _sp = 0; while (cond) { __builtin_amdgcn_s_sleep(1); \
    if ((++_sp & 255u) == 0u) { if (xb_ld(&(bar)[XB_TMO])) break; if (_sp > XB_SPIN_CAP) { atomicAdd(&(bar)[XB_TMO], 1u); break; } } } } while (0)
struct XcdBarrier { unsigned* bar; unsigned x; volatile LAS unsigned* st; };
__device__ __forceinline__ XcdBarrier xcd_barrier_post(unsigned* bar, volatile LAS unsigned* st) {
    XcdBarrier b; b.bar = bar; b.x = xb_xcc_id(); b.st = st;
    if (threadIdx.x == 0) (void)xb_add(&bar[XB_XCNT(b.x)], 1u);
    return b;
}
__device__ __forceinline__ void xcd_barrier_complete(unsigned* bar, unsigned x, unsigned& nloc, unsigned& nx) {
    const unsigned G = gridDim.x * gridDim.y * gridDim.z;
    unsigned sum, cnt, mine, sp = 0u;
    for (;;) {
        sum = 0u; cnt = 0u; mine = 0u;
#pragma unroll
        for (unsigned j = 0; j < 16; ++j) { const unsigned c = xb_ld(&bar[XB_XCNT(j)]); sum += c; cnt += (c > 0u) ? 1u : 0u; mine = (j == x) ? c : mine; }
        if (sum == G) break;
        __builtin_amdgcn_s_sleep(1);
        if ((++sp & 255u) == 0u) { if (xb_ld(&bar[XB_TMO])) break; if (sp > XB_SPIN_CAP) { atomicAdd(&bar[XB_TMO], 1u); break; } }
    }
    nloc = mine > 0u ? mine : 1u; nx = cnt > 0u ? cnt : 1u;
}
__device__ __forceinline__ void xcd_barrier(const XcdBarrier& b) {
    asm volatile("s_waitcnt vmcnt(0)" ::: "memory");
    __syncthreads();
    if (threadIdx.x == 0) {
        unsigned* bar = b.bar;
        __builtin_amdgcn_s_waitcnt(0);
        unsigned nloc = b.st[0], nx = b.st[1];
        if (nloc == 0u) { xcd_barrier_complete(bar, b.x, nloc, nx); b.st[0] = nloc; b.st[1] = nx; }
        const unsigned old = xb_add(&bar[XB_XSUB(b.x)], 1u);
        const unsigned gen = old / nloc;
        if (old + 1u == (gen + 1u) * nloc) {
            __builtin_amdgcn_fence(__ATOMIC_RELEASE, "agent");
            asm volatile("s_waitcnt vmcnt(0)" ::: "memory");
            const unsigned og = xb_add(&bar[XB_TOP], 1u);
            const unsigned tg = og / nx;
            if (og + 1u == (tg + 1u) * nx) xb_add(&bar[XB_TOPGEN], 1u);
            else XB_SPIN(xb_ld(&bar[XB_TOPGEN]) == tg, bar);
            __builtin_amdgcn_fence(__ATOMIC_ACQUIRE, "agent");
            xb_add(&bar[XB_XGEN(b.x)], 1u);
            asm volatile("s_waitcnt vmcnt(0)" ::: "memory");
        } else {
            XB_SPIN(xb_ld(&bar[XB_XGEN(b.x)]) == gen, bar);
            __builtin_amdgcn_fence(__ATOMIC_ACQUIRE, "agent");
            asm volatile("s_waitcnt vmcnt(0)" ::: "memory");
        }
    }
    __syncthreads();
}

namespace pg {
constexpr int BM = 256, BK = 64, HALF = 128, HTB = HALF * BK * 2, STAGE_BYTES = 8 * HTB, NXCD = 8, WGM = 8;
__host__ __device__ __forceinline__ int lds_byte(int r, int c) { const int st = (r >> 4) * 2 + (c >> 5), rr = r & 15, cc = c & 31, ob = rr * 64 + cc * 2; return st * 1024 + (ob ^ (((ob >> 9) & 1) << 5)); }
__host__ __device__ __forceinline__ void stage_rc(int b, int& R, int& C) { const int st = b / 1024, sb = b % 1024, swz = sb ^ (((sb >> 9) & 1) << 5); R = (st >> 1) * 16 + swz / 64; C = (st & 1) * 32 + (swz % 64) / 2; }
__host__ __device__ __forceinline__ int perm32(int rho) { const int n = rho >> 4, i = rho & 15; return 8 * (i >> 2) + 4 * n + (i & 3); }

struct Unit { int pm, pn, arow, nrows, grp; };
typedef f32x4 Acc[2][2][4][2];

template <class Epi, class Sched, class Ops>
__device__ __forceinline__ void gemm_phase(LAS unsigned char* lds, const Ops& O, const Sched& S, const Epi& E) {
    const int tid = threadIdx.x, wid = __builtin_amdgcn_readfirstlane(tid >> 6), lane = tid & 63, wr = wid >> 2, wc = wid & 3, fr = lane & 15, fq = lane >> 4;
    const int K = O.K, nt = K / BK, ldb = O.ldb;
    int Rr[2], Cc[2]; unsigned voffB[2];
#pragma unroll
    for (int i = 0; i < 2; ++i) { stage_rc(tid * 16 + i * 8192, Rr[i], Cc[i]); const int Rb = Epi::PERM ? ((Rr[i] & ~31) + perm32(Rr[i] & 31)) : Rr[i]; voffB[i] = (unsigned)(Rb * ldb + Cc[i]) * 2u; }
    const size_t kstep = (size_t)(BK * 2);
    const size_t hstepB = (size_t)HALF * ldb * 2;
    const unsigned ldsw = (unsigned)wid * 1024u;
    const int aoff = lds_byte(wr * 64 + fr, fq * 8), boff = lds_byte(wc * 32 + fr, fq * 8);
    const char* const Ab = O.abase;
#define PG_SA(b, h) (((b) * 2 + (h)) * HTB)
#define PG_SB(b, h) ((4 + (b) * 2 + (h)) * HTB)
#define PG_STAGE_B(bufoff, gbase) do { _Pragma("unroll") for (int _i = 0; _i < 2; ++_i) \
        __builtin_amdgcn_global_load_lds((const unsigned*)((const char*)(gbase) + voffB[_i]), (LAS unsigned*)(lds + (bufoff) + ldsw + _i * 8192), 16, 0, 0); } while (0)
#define PG_STAGE_A(bufoff, offs, h, kb) do { _Pragma("unroll") for (int _i = 0; _i < 2; ++_i) \
        __builtin_amdgcn_global_load_lds((const unsigned*)(Ab + (size_t)(offs)[h][_i] + (size_t)(kb)), (LAS unsigned*)(lds + (bufoff) + ldsw + _i * 8192), 16, 0, 0); } while (0)
#define PG_LDA(dst, b, h) do { _Pragma("unroll") for (int m = 0; m < 4; ++m) _Pragma("unroll") for (int k = 0; k < 2; ++k) dst[m][k] = *(const LAS bf16x8*)(lds + PG_SA(b, h) + aoff + m * 2048 + k * 1024); } while (0)
#define PG_LDB(dst, b, h) do { _Pragma("unroll") for (int n = 0; n < 2; ++n) _Pragma("unroll") for (int k = 0; k < 2; ++k) dst[n][k] = *(const LAS bf16x8*)(lds + PG_SB(b, h) + boff + n * 2048 + k * 1024); } while (0)
#define PG_MMA(ai, bj, At, Bt) do { __builtin_amdgcn_s_setprio(1); _Pragma("unroll") for (int m = 0; m < 4; ++m) _Pragma("unroll") for (int n = 0; n < 2; ++n) _Pragma("unroll") for (int k = 0; k < 2; ++k) \
        acc[ai][bj][m][n] = __builtin_amdgcn_mfma_f32_16x16x32_bf16(Bt[n][k], At[m][k], acc[ai][bj][m][n], 0, 0, 0); __builtin_amdgcn_s_setprio(0); } while (0)
#define PG_WAIT_V(n) asm volatile("s_waitcnt vmcnt(" #n ")" ::: "memory")
#define PG_WAIT_L(n) asm volatile("s_waitcnt lgkmcnt(" #n ")" ::: "memory")
#define PG_BAR __builtin_amdgcn_s_barrier()
#define PG_SCHED __builtin_amdgcn_sched_barrier(0)
    Unit cur, nxt; int ui = 0;
    if (!S.next(0, cur)) return;
    Acc acc;
#pragma unroll
    for (int a = 0; a < 2; ++a)
#pragma unroll
        for (int b = 0; b < 2; ++b)
#pragma unroll
            for (int m = 0; m < 4; ++m)
#pragma unroll
                for (int n = 0; n < 2; ++n) acc[a][b][m][n] = (f32x4){0.f, 0.f, 0.f, 0.f};
    bf16x8 At[4][2], B0[2][2], B1[2][2];
    unsigned cOff[2][2], nOff[2][2];
#pragma unroll
    for (int h = 0; h < 2; ++h)
#pragma unroll
        for (int i = 0; i < 2; ++i) cOff[h][i] = O.row_off(cur, h * HALF + Rr[i]) + (unsigned)Cc[i] * 2u;
    const char* cB = O.bptr(cur);
    PG_STAGE_B(PG_SB(0, 0), cB); PG_STAGE_B(PG_SB(0, 1), cB + hstepB); PG_STAGE_A(PG_SA(0, 0), cOff, 0, 0); PG_STAGE_A(PG_SA(0, 1), cOff, 1, 0);
    if (wr == 1) PG_BAR;
    PG_WAIT_V(2); PG_BAR;
    PG_STAGE_B(PG_SB(1, 0), cB + kstep); PG_STAGE_A(PG_SA(1, 0), cOff, 0, kstep); PG_STAGE_B(PG_SB(1, 1), cB + hstepB + kstep);
    PG_WAIT_V(6); PG_BAR;
    for (;;) {
        const bool has_next = S.next(ui + 1, nxt);
        const char* nB = cB;
#pragma unroll
        for (int h = 0; h < 2; ++h)
#pragma unroll
            for (int i = 0; i < 2; ++i) nOff[h][i] = cOff[h][i];
        if (has_next) {
            nB = O.bptr(nxt);
#pragma unroll
            for (int h = 0; h < 2; ++h)
#pragma unroll
                for (int i = 0; i < 2; ++i) nOff[h][i] = O.row_off(nxt, h * HALF + Rr[i]) + (unsigned)Cc[i] * 2u;
        }
        for (int t = 0; t < nt; t += 2) {
            const bool last = (t == nt - 2);
            const size_t k1 = (size_t)(t + 1) * kstep;
            const size_t k2 = last ? (size_t)0 : (size_t)(t + 2) * kstep, k3 = k2 + kstep;
            const char* b2 = last ? nB : cB + (size_t)(t + 2) * kstep; const char* b3 = b2 + kstep;
            unsigned o2[2][2];
#pragma unroll
            for (int h = 0; h < 2; ++h)
#pragma unroll
                for (int i = 0; i < 2; ++i) o2[h][i] = last ? nOff[h][i] : cOff[h][i];
            PG_LDB(B0, 0, 0); PG_LDB(B1, 0, 1); PG_SCHED; PG_LDA(At, 0, 0); PG_STAGE_A(PG_SA(1, 1), cOff, 1, k1);
            PG_WAIT_V(8); PG_WAIT_L(0); PG_BAR; PG_MMA(0, 0, At, B0); PG_MMA(0, 1, At, B1); PG_BAR; PG_SCHED;
            PG_LDA(At, 0, 1); PG_STAGE_B(PG_SB(0, 0), b2); PG_STAGE_B(PG_SB(0, 1), b2 + hstepB); PG_STAGE_A(PG_SA(0, 0), o2, 0, k2);
            PG_WAIT_V(8); PG_WAIT_L(0); PG_BAR; PG_MMA(1, 0, At, B0); PG_MMA(1, 1, At, B1); PG_BAR; PG_SCHED;
            PG_LDB(B0, 1, 0); PG_LDB(B1, 1, 1); PG_SCHED; PG_LDA(At, 1, 0); PG_STAGE_A(PG_SA(0, 1), o2, 1, k2);
            PG_WAIT_V(8); PG_WAIT_L(0); PG_BAR; PG_MMA(0, 0, At, B0); PG_MMA(0, 1, At, B1); PG_BAR; PG_SCHED;
            PG_LDA(At, 1, 1); PG_STAGE_B(PG_SB(1, 0), b3); PG_STAGE_B(PG_SB(1, 1), b3 + hstepB); PG_STAGE_A(PG_SA(1, 0), o2, 0, k3);
            PG_WAIT_V(8); PG_WAIT_L(0); PG_BAR; PG_MMA(1, 0, At, B0); PG_MMA(1, 1, At, B1); PG_BAR; PG_SCHED;
        }
        if (wr == 0) PG_BAR;
        E(acc, cur, wr, wc, fr, fq);
        if (!has_next) break;
#pragma unroll
        for (int a = 0; a < 2; ++a)
#pragma unroll
            for (int b = 0; b < 2; ++b)
#pragma unroll
                for (int m = 0; m < 4; ++m)
#pragma unroll
                    for (int n = 0; n < 2; ++n) acc[a][b][m][n] = (f32x4){0.f, 0.f, 0.f, 0.f};
        cur = nxt; cB = nB; ++ui;
#pragma unroll
        for (int h = 0; h < 2; ++h)
#pragma unroll
            for (int i = 0; i < 2; ++i) cOff[h][i] = nOff[h][i];
        if (wr == 1) PG_BAR;
    }
    PG_WAIT_V(0);
    PG_BAR;
#undef PG_SA
#undef PG_SB
#undef PG_STAGE_A
#undef PG_STAGE_B
#undef PG_LDA
#undef PG_LDB
#undef PG_MMA
#undef PG_WAIT_V
#undef PG_WAIT_L
#undef PG_BAR
#undef PG_SCHED
}
}

using pg::Unit; using pg::Acc;
struct DenseSched {
    int nM, nN, nwg, G, c;
    __device__ void init(int M, int N, int G_, int c_) { nM = (M + 255) / 256; nN = N / 256; nwg = nM * nN; G = G_; c = c_; }
    __device__ bool next(int i, Unit& u) const {
        const long L = (long)i * G + c; if (L >= nwg) return false;
        int wgid = (int)L; { const int q = nwg / pg::NXCD, r = nwg % pg::NXCD, xcd = wgid % pg::NXCD, off = wgid / pg::NXCD; wgid = (xcd < r ? xcd * (q + 1) : r * (q + 1) + (xcd - r) * q) + off; }
        const int nig = pg::WGM * nN, gid = wgid / nig, fm = gid * pg::WGM, gsz = (nM - fm) < pg::WGM ? (nM - fm) : pg::WGM;
        u.pm = fm + ((wgid % nig) % gsz); u.pn = (wgid % nig) / gsz; u.arow = u.pm * 256; u.nrows = 256; u.grp = 0; return true;
    }
};
struct DenseOps {
    const char* abase; const char* bbase; int K, lda, ldb;
    __device__ __forceinline__ unsigned row_off(const Unit& u, int r) const { return (unsigned)(u.arow + r) * (unsigned)lda * 2u; }
    __device__ __forceinline__ const char* bptr(const Unit& u) const { return bbase + (size_t)u.pn * 256 * ldb * 2; }
};
struct S5Sched {
    int G, c;
    __device__ bool next(int i, Unit& u) const {
        const int L = i * G + c; if (L >= S5G * 5) return false;
        u.grp = L / 5; u.pm = L % 5; u.pn = 0; u.arow = u.grp * S5PAD + u.pm * 256; u.nrows = u.pm < 4 ? 256 : 128; return true;
    }
};
struct S5Ops {
    const char* abase; const char* bbase; int K, lda, ldb;
    __device__ __forceinline__ unsigned row_off(const Unit& u, int r) const { return (unsigned)(u.arow + r) * (unsigned)lda * 2u; }
    __device__ __forceinline__ const char* bptr(const Unit& u) const { return bbase + (size_t)u.grp * 256 * ldb * 2; }
};
struct MoeSched {
    const LAS int* tstart; const LAS int* ecnt; const LAS int* estart; int nN, G, c;
    __device__ bool next(int i, Unit& u) const {
        const int L = i * G + c; const int total = tstart[NE];
        if (L >= total * nN) return false;
        const int mtg = L / nN; u.pn = L % nN;
        int e = 0;
#pragma unroll 1
        for (int s = 16; s >= 1; s >>= 1) if (tstart[e + s] <= mtg) e += s;
        u.grp = e; u.pm = mtg - tstart[e]; u.arow = estart[e] + 256 * u.pm; const int left = ecnt[e] - 256 * u.pm; u.nrows = left < 256 ? left : 256; return true;
    }
};
struct MoeUpOps {
    const char* abase; const char* bbase; const int* idx; int K, lda, ldb;
    __device__ __forceinline__ unsigned row_off(const Unit& u, int r) const { const int rr = r < u.nrows ? r : u.nrows - 1; return (unsigned)idx[u.arow + rr] * (unsigned)lda * 2u; }
    __device__ __forceinline__ const char* bptr(const Unit& u) const { return bbase + ((size_t)u.grp * 2048 + (size_t)u.pn * 256) * ldb * 2; }
};
struct MoeDownOps {
    const char* abase; const char* bbase; int K, lda, ldb;
    __device__ __forceinline__ unsigned row_off(const Unit& u, int r) const { return (unsigned)(u.arow + r) * (unsigned)lda * 2u; }
    __device__ __forceinline__ const char* bptr(const Unit& u) const { return bbase + ((size_t)u.grp * 1024 + (size_t)u.pn * 256) * ldb * 2; }
};

struct EpiBf16Gelu {
    static constexpr bool PERM = true;
    bf16* O; int ldc;
    __device__ __forceinline__ void operator()(const Acc& acc, const Unit& u, int wr, int wc, int fr, int fq) const {
        const int row0 = u.arow + wr * 64 + fr, col0 = u.pn * 256 + wc * 32 + 8 * fq;
#pragma unroll
        for (int ai = 0; ai < 2; ++ai)
#pragma unroll
            for (int m = 0; m < 4; ++m) { bf16* rowp = O + (size_t)(row0 + ai * 128 + m * 16) * ldc + col0;
#pragma unroll
                for (int bj = 0; bj < 2; ++bj) { const f32x4 v0 = gelu4(acc[ai][bj][m][0]), v1 = gelu4(acc[ai][bj][m][1]);
                    u32x4 w; w.x = cvt_pk_bf16(v0[0], v0[1]); w.y = cvt_pk_bf16(v0[2], v0[3]); w.z = cvt_pk_bf16(v1[0], v1[1]); w.w = cvt_pk_bf16(v1[2], v1[3]);
                    *(u32x4*)(rowp + bj * 128) = w; } }
    }
};
struct EpiVT {
    static constexpr bool PERM = true;
    bf16* VT; int ldc; float* vssq; int ntok;
    __device__ __forceinline__ void operator()(const Acc& acc, const Unit& u, int wr, int wc, int fr, int fq) const {
        const int row0 = u.arow + wr * 64 + fr, col0 = u.pn * 256 + wc * 32 + 8 * fq;
#pragma unroll
        for (int bj = 0; bj < 2; ++bj) {
            float ss[2][4];
#pragma unroll
            for (int n = 0; n < 2; ++n)
#pragma unroll
                for (int j = 0; j < 4; ++j) ss[n][j] = 0.f;
#pragma unroll
            for (int ai = 0; ai < 2; ++ai)
#pragma unroll
                for (int m = 0; m < 4; ++m) { bf16* rowp = VT + (size_t)(row0 + ai * 128 + m * 16) * ldc + col0 + bj * 128;
                    const f32x4 v0 = gelu4(acc[ai][bj][m][0]), v1 = gelu4(acc[ai][bj][m][1]);
#pragma unroll
                    for (int j = 0; j < 4; ++j) { ss[0][j] += v0[j] * v0[j]; ss[1][j] += v1[j] * v1[j]; }
                    u32x4 w; w.x = cvt_pk_bf16(v0[0], v0[1]); w.y = cvt_pk_bf16(v0[2], v0[3]); w.z = cvt_pk_bf16(v1[0], v1[1]); w.w = cvt_pk_bf16(v1[2], v1[3]);
                    *(u32x4*)rowp = w; }
#pragma unroll
            for (int n = 0; n < 2; ++n)
#pragma unroll
                for (int j = 0; j < 4; ++j) { float t = ss[n][j]; t += __shfl_xor(t, 1); t += __shfl_xor(t, 2); t += __shfl_xor(t, 4); t += __shfl_xor(t, 8); ss[n][j] = t; }
            if (fr == 0) { float* p = vssq + (size_t)(u.pm * 2 + wr) * ntok + col0 + bj * 128;
                *(f32x4*)p = (f32x4){ss[0][0], ss[0][1], ss[0][2], ss[0][3]}; *(f32x4*)(p + 4) = (f32x4){ss[1][0], ss[1][1], ss[1][2], ss[1][3]}; }
            asm volatile("" ::: "memory");
        }
    }
};
struct EpiResid {
    static constexpr bool PERM = false;
    float* H; const float* mod; int goff;
    __device__ __forceinline__ void operator()(const Acc& acc, const Unit& u, int wr, int wc, int fr, int fq) const {
        const int row0 = u.arow + wr * 64 + fr, col0 = u.pn * 256 + wc * 32 + 4 * fq;
        const int b = u.arow < TL ? (u.arow >> 11) : 8;
        const float* gp = mod + (size_t)b * 6144 + goff + col0;
        f32x4 gv[2][2];
#pragma unroll
        for (int bj = 0; bj < 2; ++bj)
#pragma unroll
            for (int n = 0; n < 2; ++n) gv[bj][n] = *(const f32x4*)(gp + bj * 128 + n * 16);
#pragma unroll
        for (int ai = 0; ai < 2; ++ai)
#pragma unroll
            for (int m = 0; m < 4; ++m) { float* rowp = H + (size_t)(row0 + ai * 128 + m * 16) * D + col0;
                f32x4 hv[2][2];
#pragma unroll
                for (int bj = 0; bj < 2; ++bj)
#pragma unroll
                    for (int n = 0; n < 2; ++n) hv[bj][n] = *(const f32x4*)(rowp + bj * 128 + n * 16);
#pragma unroll
                for (int bj = 0; bj < 2; ++bj)
#pragma unroll
                    for (int n = 0; n < 2; ++n) *(f32x4*)(rowp + bj * 128 + n * 16) = hv[bj][n] + gv[bj][n] * acc[ai][bj][m][n];
                if (m & 1) asm volatile("" ::: "memory"); }
    }
};
struct EpiMoeUp {
    static constexpr bool PERM = false;
    bf16* ACT; const float* bgate; const float* bup;
    __device__ __forceinline__ void operator()(const Acc& acc, const Unit& u, int wr, int wc, int fr, int fq) const {
        const int col0 = u.pn * 128 + wc * 32 + 8 * fq;
        const float* bg = bgate + (size_t)u.grp * 1024 + col0; const float* bu = bup + (size_t)u.grp * 1024 + col0;
        f32x4 bgv[2], buv[2];
#pragma unroll
        for (int bj = 0; bj < 2; ++bj) { bgv[bj] = *(const f32x4*)(bg + 4 * bj); buv[bj] = *(const f32x4*)(bu + 4 * bj); }
#pragma unroll
        for (int ai = 0; ai < 2; ++ai)
#pragma unroll
            for (int m = 0; m < 4; ++m) { const int r = ai * 128 + wr * 64 + m * 16 + fr;
                float a[8];
#pragma unroll
                for (int bj = 0; bj < 2; ++bj)
#pragma unroll
                    for (int j = 0; j < 4; ++j) { const float g = fminf(acc[ai][bj][m][0][j] + bgv[bj][j], 7.0f); const float uu = fminf(fmaxf(acc[ai][bj][m][1][j] + buv[bj][j], -7.0f), 7.0f);
                        a[bj * 4 + j] = g * sigmoidf_(1.702f * g) * (uu + 1.0f); }
                u32x4 w; w.x = cvt_pk_bf16(a[0], a[1]); w.y = cvt_pk_bf16(a[2], a[3]); w.z = cvt_pk_bf16(a[4], a[5]); w.w = cvt_pk_bf16(a[6], a[7]);
                if (r < u.nrows) *(u32x4*)(ACT + (size_t)(u.arow + r) * 1024 + col0) = w; }
    }
};
struct EpiMoeDown {
    static constexpr bool PERM = true;
    bf16* Y; const float* bdown; const float* sgate;
    __device__ __forceinline__ void operator()(const Acc& acc, const Unit& u, int wr, int wc, int fr, int fq) const {
        const int col0 = u.pn * 256 + wc * 32 + 8 * fq;
        const float* bp = bdown + (size_t)u.grp * 1024 + col0;
        f32x4 bv[2][2];
#pragma unroll
        for (int bj = 0; bj < 2; ++bj)
#pragma unroll
            for (int n = 0; n < 2; ++n) bv[bj][n] = *(const f32x4*)(bp + bj * 128 + 4 * n);
#pragma unroll
        for (int ai = 0; ai < 2; ++ai)
#pragma unroll
            for (int m = 0; m < 4; ++m) { const int r = ai * 128 + wr * 64 + m * 16 + fr; const bool ok = r < u.nrows;
                const float gt = ok ? sgate[u.arow + r] : 0.f; bf16* rowp = Y + (size_t)(u.arow + r) * 1024 + col0;
#pragma unroll
                for (int bj = 0; bj < 2; ++bj) { const f32x4 v0 = (acc[ai][bj][m][0] + bv[bj][0]) * gt, v1 = (acc[ai][bj][m][1] + bv[bj][1]) * gt;
                    u32x4 w; w.x = cvt_pk_bf16(v0[0], v0[1]); w.y = cvt_pk_bf16(v0[2], v0[3]); w.z = cvt_pk_bf16(v1[0], v1[1]); w.w = cvt_pk_bf16(v1[2], v1[3]);
                    if (ok) *(u32x4*)(rowp + bj * 128) = w; } }
    }
};
struct EpiS5In {
    static constexpr bool PERM = true;
    bf16* XH;
    __device__ __forceinline__ void operator()(const Acc& acc, const Unit& u, int wr, int wc, int fr, int fq) const {
        const int row0 = u.arow + wr * 64 + fr, col0 = u.pn * 256 + wc * 32 + 8 * fq;
#pragma unroll
        for (int ai = 0; ai < 2; ++ai)
#pragma unroll
            for (int m = 0; m < 4; ++m) { const int row = row0 + ai * 128 + m * 16;
#pragma unroll
                for (int bj = 0; bj < 2; ++bj) { const int c = col0 + bj * 128, g = c >> 4, cc = c & 15; const f32x4 v0 = acc[ai][bj][m][0], v1 = acc[ai][bj][m][1];
                    u32x4 w; w.x = cvt_pk_bf16(v0[0], v0[1]); w.y = cvt_pk_bf16(v0[2], v0[3]); w.z = cvt_pk_bf16(v1[0], v1[1]); w.w = cvt_pk_bf16(v1[2], v1[3]);
                    *(u32x4*)(XH + ((size_t)g * S5PAD + (row >> 4)) * 512 + (row & 15) * 16 + cc) = w; } }
    }
};
struct EpiS5State {
    static constexpr bool PERM = false;
    float* S;
    __device__ __forceinline__ void operator()(const Acc& acc, const Unit& u, int wr, int wc, int fr, int fq) const {
        const int col0 = wc * 32 + 4 * fq;
#pragma unroll
        for (int ai = 0; ai < 2; ++ai)
#pragma unroll
            for (int m = 0; m < 4; ++m) { const int r = ai * 128 + wr * 64 + m * 16 + fr; float* rowp = S + (size_t)(u.arow + r) * 256 + col0;
                if (r < u.nrows) {
#pragma unroll
                    for (int bj = 0; bj < 2; ++bj)
#pragma unroll
                        for (int n = 0; n < 2; ++n) *(f32x4*)(rowp + bj * 128 + n * 16) = acc[ai][bj][m][n]; } }
    }
};
struct EpiS5Out {
    static constexpr bool PERM = true;
    bf16* Y;
    __device__ __forceinline__ void operator()(const Acc& acc, const Unit& u, int wr, int wc, int fr, int fq) const {
        const int n0 = wc * 32 + 8 * fq;
#pragma unroll
        for (int ai = 0; ai < 2; ++ai)
#pragma unroll
            for (int m = 0; m < 4; ++m) { const int r = ai * 128 + wr * 64 + m * 16 + fr; const int crow = u.pm * 256 + r;
                if (r < u.nrows) {
#pragma unroll
                    for (int bj = 0; bj < 2; ++bj) { const int n = n0 + bj * 128, t = n >> 4, c = n & 15; const f32x4 v0 = gelu4(acc[ai][bj][m][0]), v1 = gelu4(acc[ai][bj][m][1]);
                        u32x4 w; w.x = cvt_pk_bf16(v0[0], v0[1]); w.y = cvt_pk_bf16(v0[2], v0[3]); w.z = cvt_pk_bf16(v1[0], v1[1]); w.w = cvt_pk_bf16(v1[2], v1[3]);
                        *(u32x4*)(Y + (size_t)(crow * 16 + t) * D + u.grp * 16 + c) = w; } } }
    }
};
struct EpiGlu {
    static constexpr bool PERM = false;
    float* H; const float* mod; int goff;
    __device__ __forceinline__ void operator()(const Acc& acc, const Unit& u, int wr, int wc, int fr, int fq) const {
        const int row0 = u.arow + wr * 64 + fr, col0 = u.pn * 128 + wc * 32 + 8 * fq;
        const int b = u.arow < TL ? (u.arow >> 11) : 8;
        const float* gp = mod + (size_t)b * 6144 + goff + col0;
        f32x4 gv[2];
#pragma unroll
        for (int bj = 0; bj < 2; ++bj) gv[bj] = *(const f32x4*)(gp + 4 * bj);
#pragma unroll
        for (int ai = 0; ai < 2; ++ai)
#pragma unroll
            for (int m = 0; m < 4; ++m) { float* rowp = H + (size_t)(row0 + ai * 128 + m * 16) * D + col0;
                f32x4 hv[2];
#pragma unroll
                for (int bj = 0; bj < 2; ++bj) hv[bj] = *(const f32x4*)(rowp + 4 * bj);
#pragma unroll
                for (int bj = 0; bj < 2; ++bj) { f32x4 o;
#pragma unroll
                    for (int j = 0; j < 4; ++j) o[j] = hv[bj][j] + gv[bj][j] * acc[ai][bj][m][0][j] * sigmoidf_(acc[ai][bj][m][1][j]);
                    *(f32x4*)(rowp + 4 * bj) = o; }
                if (m & 1) asm volatile("" ::: "memory"); }
    }
};
struct EpiMlaIn {
    static constexpr bool PERM = true;
    bf16* Z; float* ssq;
    __device__ __forceinline__ void operator()(const Acc& acc, const Unit& u, int wr, int wc, int fr, int fq) const {
        const int row0 = u.arow + wr * 64 + fr, col0 = u.pn * 256 + wc * 32 + 8 * fq;
#pragma unroll
        for (int ai = 0; ai < 2; ++ai)
#pragma unroll
            for (int m = 0; m < 4; ++m) { const int row = row0 + ai * 128 + m * 16; bf16* rowp = Z + (size_t)row * 768 + col0;
#pragma unroll
                for (int bj = 0; bj < 2; ++bj) { const f32x4 v0 = acc[ai][bj][m][0], v1 = acc[ai][bj][m][1];
                    float s = (v0[0] * v0[0] + v0[1] * v0[1]) + (v0[2] * v0[2] + v0[3] * v0[3]) + (v1[0] * v1[0] + v1[1] * v1[1]) + (v1[2] * v1[2] + v1[3] * v1[3]);
                    s += __shfl_xor(s, 16); s += __shfl_xor(s, 32);
                    u32x4 w; w.x = cvt_pk_bf16(v0[0], v0[1]); w.y = cvt_pk_bf16(v0[2], v0[3]); w.z = cvt_pk_bf16(v1[0], v1[1]); w.w = cvt_pk_bf16(v1[2], v1[3]);
                    *(u32x4*)(rowp + bj * 128) = w;
                    if (fq == 0) ssq[(size_t)row * 24 + u.pn * 8 + bj * 4 + wc] = s; } }
    }
};
template <int MODE> struct EpiMlaUp {
    static constexpr bool PERM = true;
    bf16* O0; bf16* O1; const float* ssq; int s0, ns; float inv_n;
    __device__ __forceinline__ void operator()(const Acc& acc, const Unit& u, int wr, int wc, int fr, int fq) const {
        const int row0 = u.arow + wr * 64 + fr, cl = wc * 32 + 8 * fq;
        const int b = u.arow < TL ? (u.arow >> 11) : ((u.arow - TL) >> 8), key0 = u.arow < TL ? (CTXL + (u.arow & 2047)) : 0;
#pragma unroll
        for (int ai = 0; ai < 2; ++ai)
#pragma unroll
            for (int m = 0; m < 4; ++m) { const int row = row0 + ai * 128 + m * 16; const int rt = wr * 64 + fr + ai * 128 + m * 16;
                const float* sp = ssq + (size_t)row * 24 + s0; float s = 0.f;
                for (int q = 0; q < ns; q += 4) { const f32x4 t = *(const f32x4*)(sp + q); s += (t[0] + t[1]) + (t[2] + t[3]); }
                const float rs = 1.0f / sqrtf(s * inv_n + EPS);
#pragma unroll
                for (int bj = 0; bj < 2; ++bj) { const f32x4 v0 = acc[ai][bj][m][0] * rs, v1 = acc[ai][bj][m][1] * rs;
                    u32x4 w; w.x = cvt_pk_bf16(v0[0], v0[1]); w.y = cvt_pk_bf16(v0[2], v0[3]); w.z = cvt_pk_bf16(v1[0], v1[1]); w.w = cvt_pk_bf16(v1[2], v1[3]);
                    if (MODE == 0) *(u32x4*)(O0 + (size_t)row * 1536 + u.pn * 256 + bj * 128 + cl) = w;
                    else { const size_t kr = ((size_t)(b * NH + u.pn) * KEYS + key0 + rt);
                        if (bj == 0) *(u32x4*)(O0 + kr * DQK + cl) = w; else *(u32x4*)(O1 + kr * DV + cl) = w; } } }
    }
};

constexpr size_t WS_WRT = 60 * MiB;
struct Frame {
    LAS unsigned char* lds; LAS unsigned char* misc;
    unsigned* ctl; unsigned char* ws;
    int tid, lane, wave, vcu, G;
    const float* const* in;
};
template <class Map>
__device__ __forceinline__ void transpose_half(const float* src, int ld, int ncv, int K, int k0, const float* scale, bf16* dst, const Map& map, LAS float* scr, int lane) {
    const int c = lane & 31;
#pragma unroll 8
    for (int i = 0; i < 32; ++i) { const int kk = 2 * i + (lane >> 5); float v = (c < ncv) ? src[(size_t)(k0 + kk) * ld + c] : 0.f; if (scale) v *= scale[k0 + kk]; scr[kk * 33 + c] = v; }
    LDS_WAIT(); asm volatile("" ::: "memory");
    const int c8 = lane & 7;
#pragma unroll
    for (int j = 0; j < 4; ++j) { const int n = (lane >> 3) + 8 * j; const LAS float* s = scr + (8 * c8) * 33 + n;
        u32x4 o; o.x = pk2(s[0 * 33], s[1 * 33]); o.y = pk2(s[2 * 33], s[3 * 33]); o.z = pk2(s[4 * 33], s[5 * 33]); o.w = pk2(s[6 * 33], s[7 * 33]);
        *(u32x4*)(dst + (size_t)map(n) * K + k0 + 8 * c8) = o; }
    LDS_WAIT(); asm volatile("" ::: "memory");
}
struct MapPlain { int n0; __device__ __forceinline__ int operator()(int j) const { return n0 + j; } };
struct MapPair { int cb, ty; __device__ __forceinline__ int operator()(int o) const { return 256 * (cb >> 2) + 128 * ((o >> 2) & 1) + 32 * (cb & 3) + 16 * ty + 4 * (o >> 3) + (o & 3); } };
__device__ __forceinline__ void tr_plain(const float* W, int K, int N, int Npad, const float* scale, bf16* WT, int it, LAS float* scr, int lane) {
    const int nblk = Npad / 32, kb = it / nblk, nb = it % nblk; const int ncv = N - nb * 32;
    transpose_half(W + nb * 32, N, ncv, K, kb * 64, scale, WT, MapPlain{nb * 32}, scr, lane);
}
__device__ __forceinline__ void tr_pair(const float* A, const float* B, int K, int N, int ld, bf16* WT, int it, LAS float* scr, int lane) {
    const int nblk = N / 32, ty = it & 1, r = it >> 1, kb = r / nblk, cb = r % nblk;
    transpose_half((ty ? B : A) + cb * 32, ld, 32, K, kb * 64, nullptr, WT, MapPair{cb, ty}, scr, lane);
}

__device__ __forceinline__ void p0_prologue(Frame& F) {
    const float* const* in = F.in;
    unsigned char* ws = F.ws;
    LAS float* silu = (LAS float*)(F.lds + 90112);
    for (int i = F.tid; i < 9 * 1024; i += NTHREADS) { const float c = i < 8192 ? in[1][i] : in[3][i - 8192]; silu[i] = c * sigmoidf_(c); }
    __syncthreads();
    {
        LAS float* red = (LAS float*)F.lds;
        float* MOD = (float*)(ws + WS_MOD);
        for (int it = F.vcu; it < DEPTH * 96; it += F.G) {
            const int l = it / 96, cb = it % 96, col = cb * 64 + F.lane;
            const float* w = in[4] + (size_t)l * 1024 * 6144 + col;
            float acc[9];
#pragma unroll
            for (int r = 0; r < 9; ++r) acc[r] = 0.f;
            const int kbase = F.wave * 128;
#pragma unroll 8
            for (int k = 0; k < 128; ++k) { const float wv = w[(size_t)(kbase + k) * 6144];
#pragma unroll
                for (int r = 0; r < 9; ++r) acc[r] += silu[r * 1024 + kbase + k] * wv; }
#pragma unroll
            for (int r = 0; r < 9; ++r) red[(F.wave * 9 + r) * 64 + F.lane] = acc[r];
            __syncthreads();
            for (int o = F.tid; o < 9 * 64; o += NTHREADS) { const int r = o / 64, c = o % 64; float s = 0.f;
#pragma unroll
                for (int wv = 0; wv < 8; ++wv) s += red[(wv * 9 + r) * 64 + c];
                MOD[((size_t)l * 9 + r) * 6144 + cb * 64 + c] = s + in[5][(size_t)l * 6144 + cb * 64 + c]; }
            __syncthreads();
        }
    }
    if (F.vcu >= F.G - S5G) {
        const int g = F.vcu - (F.G - S5G);
        LAS float* apr = (LAS float*)F.lds;
        LAS float* api = apr + 2 * 64 * 17;
        LAS float* bbr = api + 2 * 64 * 17;
        LAS float* bbi = bbr + 2 * 64 * 16;
        LAS float* ccr = bbi + 2 * 64 * 16;
        LAS float* cci = ccr + 2 * 16 * 64;
        LAS float* klg = cci + 2 * 16 * 64;
        static_assert((2 * 64 * 17 * 2 + 2 * 64 * 16 * 2 + 2 * 16 * 64 * 2 + 2 * 16 * 256) * 4 <= 90112, "S5 scratch");
        const float* lam_re = in[14]; const float* lam_im = in[15]; const float* log_dt = in[16];
        const float* b_re = in[17]; const float* b_im = in[18]; const float* c_re = in[19]; const float* c_im = in[20]; const float* dsk = in[21];
        if (F.tid < 128) {
            const int dir = F.tid >> 6, p = F.tid & 63; const int gp = (dir * S5G + g) * 64 + p;
            const float dt = expf(log_dt[dir * S5G + g]), lr = lam_re[gp], li = lam_im[gp];
            const float mag = expf(lr * dt); float sn, cs; sincosf(li * dt, &sn, &cs); const float ar = mag * cs, ai = mag * sn;
            { float pr = 1.0f, pi = 0.0f;
              for (int l = 0; l <= 16; ++l) { apr[(dir * 64 + p) * 17 + l] = pr; api[(dir * 64 + p) * 17 + l] = pi; const float t = pr * ar - pi * ai; pi = pr * ai + pi * ar; pr = t; } }
            const float den = lr * lr + li * li, nr = ar - 1.0f; const float fr_ = (nr * lr + ai * li) / den, fi_ = (ai * lr - nr * li) / den;
            for (int c = 0; c < 16; ++c) { const float br = b_re[(size_t)gp * 16 + c], bi = b_im[(size_t)gp * 16 + c]; bbr[(dir * 64 + p) * 16 + c] = fr_ * br - fi_ * bi; bbi[(dir * 64 + p) * 16 + c] = fr_ * bi + fi_ * br; }
            float* A16 = (float*)(ws + WS_A16) + ((size_t)(g * 2 + dir) * 2) * 64;
            A16[p] = apr[(dir * 64 + p) * 17 + 16]; A16[64 + p] = api[(dir * 64 + p) * 17 + 16];
        }
        for (int i = F.tid; i < 2 * 16 * 64; i += NTHREADS) { const int dir = i / 1024, r = i % 1024; ccr[i] = c_re[((size_t)(dir * S5G + g)) * 1024 + r]; cci[i] = c_im[((size_t)(dir * S5G + g)) * 1024 + r]; }
        __syncthreads();
        {
            const int dir = F.tid >> 8, l = (F.tid >> 4) & 15, c = F.tid & 15;
            float acc[16];
#pragma unroll
            for (int q = 0; q < 16; ++q) acc[q] = 0.f;
            for (int p = 0; p < 64; ++p) { const float cr = ccr[(dir * 16 + c) * 64 + p], ci = cci[(dir * 16 + c) * 64 + p], ar = apr[(dir * 64 + p) * 17 + l], ai = api[(dir * 64 + p) * 17 + l];
                const float zr = cr * ar - ci * ai, zi = cr * ai + ci * ar;
#pragma unroll
                for (int q = 0; q < 16; ++q) acc[q] += zr * bbr[(dir * 64 + p) * 16 + q] - zi * bbi[(dir * 64 + p) * 16 + q]; }
#pragma unroll
            for (int q = 0; q < 16; ++q) klg[((dir * 16 + l) * 16 + c) * 16 + q] = acc[q];
        }
        __syncthreads();
        bf16* TET = (bf16*)(ws + WS_TET) + (size_t)g * 256 * 512; bf16* GT = (bf16*)(ws + WS_GT) + (size_t)g * 256 * 256;
        for (int q = F.tid; q < 256 * 64; q += NTHREADS) { const int n = q >> 6, kc = q & 63, t = n >> 4, c = n & 15; float v[8];
            if (kc < 32) { const int s = kc >> 1, c0 = (kc & 1) * 8;
#pragma unroll
                for (int j = 0; j < 8; ++j) { float x = 0.f; if (s <= t) x += klg[((0 * 16 + (t - s)) * 16 + c) * 16 + c0 + j]; if (s >= t) x += klg[((1 * 16 + (s - t)) * 16 + c) * 16 + c0 + j];
                    if (s == t && c == c0 + j) x += dsk[g * 16 + c]; v[j] = x; }
            } else { const int kk = (kc - 32) * 8, dir = kk >> 7, ri = (kk >> 6) & 1, p0 = kk & 63; const int pw = dir == 0 ? (t + 1) : (16 - t);
#pragma unroll
                for (int j = 0; j < 8; ++j) { const int p = p0 + j; const float cr = ccr[(dir * 16 + c) * 64 + p], ci = cci[(dir * 16 + c) * 64 + p], ar = apr[(dir * 64 + p) * 17 + pw], ai = api[(dir * 64 + p) * 17 + pw];
                    v[j] = ri == 0 ? (cr * ar - ci * ai) : -(cr * ai + ci * ar); } }
            u32x4 o; o.x = pk2(v[0], v[1]); o.y = pk2(v[2], v[3]); o.z = pk2(v[4], v[5]); o.w = pk2(v[6], v[7]);
            *(u32x4*)(TET + (size_t)n * 512 + kc * 8) = o; }
        for (int q = F.tid; q < 256 * 32; q += NTHREADS) { const int n = q >> 5, kc = q & 31, dir = n >> 7, ri = (n >> 6) & 1, p = n & 63, s = kc >> 1, c0 = (kc & 1) * 8; const int pw = dir == 0 ? (15 - s) : s;
            const float ar = apr[(dir * 64 + p) * 17 + pw], ai = api[(dir * 64 + p) * 17 + pw]; float v[8];
#pragma unroll
            for (int j = 0; j < 8; ++j) { const float br = bbr[(dir * 64 + p) * 16 + c0 + j], bi = bbi[(dir * 64 + p) * 16 + c0 + j]; v[j] = ri == 0 ? (ar * br - ai * bi) : (ar * bi + ai * br); }
            u32x4 o; o.x = pk2(v[0], v[1]); o.y = pk2(v[2], v[3]); o.z = pk2(v[4], v[5]); o.w = pk2(v[6], v[7]);
            *(u32x4*)(GT + (size_t)n * 256 + kc * 8) = o; }
        __syncthreads();
    }
    {
        const size_t gt = (size_t)F.vcu * NTHREADS + F.tid, GT_ = (size_t)F.G * NTHREADS;
        f32x4* H4 = (f32x4*)(ws + WS_H); const f32x4* x4 = (const f32x4*)in[0]; const f32x4* c4 = (const f32x4*)in[2];
        for (size_t i = gt; i < (size_t)TT * 256; i += GT_) H4[i] = i < (size_t)TL * 256 ? x4[i] : c4[i - (size_t)TL * 256];
        float* WRT = (float*)(ws + WS_WRT);
        for (size_t i = gt; i < (size_t)DEPTH * 32 * 1024; i += GT_) { const int l = (int)(i >> 15), e = (int)(i >> 10) & 31, k = (int)i & 1023; WRT[i] = in[31][((size_t)l * 1024 + k) * 32 + e]; }
    }
    {
        LAS float* scr = (LAS float*)(F.lds + F.wave * 8448);
        const int gw = F.vcu * NWAVES + F.wave, NGW = F.G * NWAVES;
        constexpr int I_SGIN = 16 * 64, I_SGOUT = 16 * 32, I_SSMIN = 16 * 32, I_GLU = 16 * 32 * 2, I_MLAIN = 16 * 24, I_UQ = 6 * 48, I_UKV = 4 * 64, I_MLAOUT = 16 * 32;
        constexpr int I_SMALL = 2 * I_SGIN + 2 * I_SGOUT + I_SSMIN + I_GLU + I_MLAIN + I_UQ + I_UKV + I_MLAOUT;
        constexpr int I_GU = 16 * 32 * 2, I_DN = 16 * 32, I_EXP = I_GU + I_DN;
        constexpr int NITEMS = I_SMALL + DEPTH * NE * I_EXP;
        for (int it = gw; it < NITEMS; it += NGW) {
            int r = it;
            if (r < 2 * I_SGIN) { const int sl = r / I_SGIN; tr_plain(in[8] + (size_t)sl * 1024 * 2048, 1024, 2048, 2048, nullptr, (bf16*)(ws + WS_WSGIN) + (size_t)sl * 2048 * 1024, r % I_SGIN, scr, F.lane); continue; } r -= 2 * I_SGIN;
            if (r < 2 * I_SGOUT) { const int sl = r / I_SGOUT; tr_plain(in[12] + (size_t)sl * 1024 * 1024, 1024, 1024, 1024, nullptr, (bf16*)(ws + WS_WSGOUT) + (size_t)sl * 1024 * 1024, r % I_SGOUT, scr, F.lane); continue; } r -= 2 * I_SGOUT;
            if (r < I_SSMIN) { tr_plain(in[13], 1024, 1024, 1024, nullptr, (bf16*)(ws + WS_WSSMIN), r, scr, F.lane); continue; } r -= I_SSMIN;
            if (r < I_GLU) { tr_pair(in[22], in[22] + 1024, 1024, 1024, 2048, (bf16*)(ws + WS_WGLU), r, scr, F.lane); continue; } r -= I_GLU;
            if (r < I_MLAIN) { tr_plain(in[23], 1024, 704, 768, nullptr, (bf16*)(ws + WS_WMLAIN), r, scr, F.lane); continue; } r -= I_MLAIN;
            if (r < I_UQ) { tr_plain(in[26], 384, 1536, 1536, in[24], (bf16*)(ws + WS_WUQ), r, scr, F.lane); continue; } r -= I_UQ;
            if (r < I_UKV) { tr_plain(in[27], 256, 2048, 2048, in[25], (bf16*)(ws + WS_WUKV), r, scr, F.lane); continue; } r -= I_UKV;
            if (r < I_MLAOUT) { tr_plain(in[30], 1024, 1024, 1024, nullptr, (bf16*)(ws + WS_WMLAOUT), r, scr, F.lane); continue; } r -= I_MLAOUT;
            const int le = r / I_EXP, q = r % I_EXP;
            if (q < I_GU) tr_pair(in[33] + (size_t)le * 1024 * 1024, in[35] + (size_t)le * 1024 * 1024, 1024, 1024, 1024, (bf16*)(ws + WS_WGU) + (size_t)le * 2048 * 1024, q, scr, F.lane);
            else tr_plain(in[37] + (size_t)le * 1024 * 1024, 1024, 1024, 1024, nullptr, (bf16*)(ws + WS_WD) + (size_t)le * 1024 * 1024, q - I_GU, scr, F.lane);
        }
    }
}

#define HALVE(NH_, M_) do { const bool up_ = (F.lane & (M_)) != 0; _Pragma("unroll") for (int i_ = 0; i_ < (NH_); ++i_) { const float a_ = lg[i_], b_ = lg[i_ + (NH_)]; \
        const float snd_ = up_ ? a_ : b_, kp_ = up_ ? b_ : a_; lg[i_] = kp_ + __shfl_xor(snd_, (M_)); } } while (0)
template <bool COMBINE, bool ROUTER>
__device__ __forceinline__ void norm_phase(Frame& F, int nrows, const float* gain, const float* modl, int shoff, int scoff,
                                           const float* modprev, const bf16* Y, const int* tokslot, float* Hbuf, bf16* NBout,
                                           const float* wrt, const float* brouter, int* tope, float* topg, unsigned* histg) {
    LAS float* wl = (LAS float*)F.lds;
    LAS int* hist = (LAS int*)(F.misc + MI_HIST);
    if (ROUTER) {
        for (int i = F.tid; i < 8192; i += NTHREADS) ((LAS f32x4*)wl)[i] = ((const f32x4*)wrt)[i];
        if (F.tid < 32) hist[F.tid] = 0;
        __syncthreads();
    }
    const int gw = F.vcu * NWAVES + F.wave, NGW = F.G * NWAVES;
    f32x4 gn[4];
#pragma unroll
    for (int j = 0; j < 4; ++j) gn[j] = ((const f32x4*)gain)[F.lane + 64 * j];
    for (int row = gw; row < nrows; row += NGW) {
        const int b = row < TL ? (row >> 11) : 8;
        f32x4* hrow = (f32x4*)(Hbuf + (size_t)row * D);
        f32x4 v[4];
#pragma unroll
        for (int j = 0; j < 4; ++j) v[j] = hrow[F.lane + 64 * j];
        if (COMBINE) {
            const f32x4* g5 = (const f32x4*)(modprev + (size_t)b * 6144 + 5120);
            f32x4 ys[4];
#pragma unroll
            for (int j = 0; j < 4; ++j) ys[j] = (f32x4){0.f, 0.f, 0.f, 0.f};
#pragma unroll
            for (int k = 0; k < 4; ++k) { const int slot = tokslot[row * 4 + k]; const u32x2* yr = (const u32x2*)(Y + (size_t)slot * D);
#pragma unroll
                for (int j = 0; j < 4; ++j) { const u32x2 y = yr[F.lane + 64 * j]; ys[j] += (f32x4){bf2f(y.x & 0xffffu), bf2f(y.x >> 16), bf2f(y.y & 0xffffu), bf2f(y.y >> 16)}; } }
#pragma unroll
            for (int j = 0; j < 4; ++j) { v[j] += g5[F.lane + 64 * j] * ys[j]; hrow[F.lane + 64 * j] = v[j]; }
        }
        float s = 0.f;
#pragma unroll
        for (int j = 0; j < 4; ++j) s += (v[j][0] * v[j][0] + v[j][1] * v[j][1]) + (v[j][2] * v[j][2] + v[j][3] * v[j][3]);
        const float rstd = 1.0f / sqrtf(wave_sum(s) * (1.0f / D) + EPS);
        const f32x4* sh = (const f32x4*)(modl + (size_t)b * 6144 + shoff); const f32x4* sc = (const f32x4*)(modl + (size_t)b * 6144 + scoff);
        u32x2* orow = (u32x2*)(NBout + (size_t)row * D);
#pragma unroll
        for (int j = 0; j < 4; ++j) { v[j] = (v[j] * rstd) * gn[j] * (sc[F.lane + 64 * j] + 1.0f) + sh[F.lane + 64 * j];
            u32x2 o; o.x = pk2(v[j][0], v[j][1]); o.y = pk2(v[j][2], v[j][3]); orow[F.lane + 64 * j] = o; }
        if (ROUTER) {
            float lg[32];
#pragma unroll
            for (int e = 0; e < 32; ++e) lg[e] = 0.f;
#pragma unroll
            for (int j = 0; j < 4; ++j)
#pragma unroll
                for (int e = 0; e < 32; ++e) { const f32x4 w4 = ((const LAS f32x4*)wl)[e * 256 + F.lane + 64 * j]; lg[e] += (v[j][0] * w4[0] + v[j][1] * w4[1]) + (v[j][2] * w4[2] + v[j][3] * w4[3]); }
            HALVE(16, 32); HALVE(8, 16); HALVE(4, 8); HALVE(2, 4); HALVE(1, 2);
            float val = lg[0] + __shfl_xor(lg[0], 1);
            const int me = F.lane >> 1;
            val += brouter[me];
            int se[4]; float sv[4];
#pragma unroll
            for (int k = 0; k < 4; ++k) { const float mx = wave_max(val); const unsigned long long bl = __ballot(val == mx); const int first = __ffsll((long long)bl) - 1; const int e = first >> 1;
                se[k] = e; sv[k] = mx; if (me == e) val = -INFINITY; }
            const float e1 = __expf(sv[1] - sv[0]), e2 = __expf(sv[2] - sv[0]), e3 = __expf(sv[3] - sv[0]); const float inv = 1.0f / (1.0f + e1 + e2 + e3);
            if (F.lane == 0) {
                *(int4*)(tope + (size_t)row * 4) = make_int4(se[0], se[1], se[2], se[3]);
                *(f32x4*)(topg + (size_t)row * 4) = (f32x4){inv, e1 * inv, e2 * inv, e3 * inv};
#pragma unroll
                for (int k = 0; k < 4; ++k) atomicAdd((int*)&hist[se[k]], 1);
            }
        }
    }
    if (ROUTER) { __syncthreads(); if (F.tid < 32) histg[F.tid] = (unsigned)hist[F.tid]; }
}

__device__ __forceinline__ void dispatch_phase(Frame& F, int nrows, const unsigned* histl  , unsigned* moetab  ,
                                               const int* tope, const float* topg, int* tokslot, int* slottok, float* slotgate) {
    LAS int* pall = (LAS int*)(F.misc + MI_SCR);
    LAS int* pbef = pall + 512;
    LAS int* cnt = (LAS int*)(F.misc + MI_HIST);
    LAS int* tot = (LAS int*)(F.misc + MI_ECNT);
    LAS int* start = (LAS int*)(F.misc + MI_ESTART);
    LAS int* wbase = (LAS int*)(F.misc + MI_TSTART);
    {
        const int e = F.tid & 31, part = F.tid >> 5; int sa = 0, sb = 0;
        const int per = (F.G + 15) / 16;
        for (int i = 0; i < per; ++i) { const int c = part * per + i; if (c < F.G) { const int hv = (int)histl[c * 32 + e]; sa += hv; if (c < F.vcu) sb += hv; } }
        pall[part * 32 + e] = sa; pbef[part * 32 + e] = sb;
    }
    __syncthreads();
    if (F.tid < 32) { int sa = 0, sb = 0;
#pragma unroll
        for (int p = 0; p < 16; ++p) { sa += pall[p * 32 + F.tid]; sb += pbef[p * 32 + F.tid]; }
        tot[F.tid] = sa; wbase[F.tid] = sb; cnt[F.tid] = 0; }
    __syncthreads();
    if (F.tid == 0) { int acc = 0; for (int e = 0; e < 32; ++e) { start[e] = acc; acc += tot[e]; } }
    __syncthreads();
    if (F.vcu == 0 && F.tid < 32) { moetab[F.tid] = (unsigned)tot[F.tid]; moetab[32 + F.tid] = (unsigned)start[F.tid]; }
    const int NGW = F.G * NWAVES, rpw = nrows / NGW;
    for (int idx = F.tid; idx < rpw * NWAVES * 4; idx += NTHREADS) {
        const int rr = idx >> 2, k = idx & 3; const int row = F.vcu * NWAVES + (rr & 7) + NGW * (rr >> 3);
        const int e = tope[row * 4 + k]; const int rank = atomicAdd((int*)&cnt[e], 1); const int slot = start[e] + wbase[e] + rank;
        slottok[slot] = row; slotgate[slot] = topg[row * 4 + k]; tokslot[row * 4 + k] = slot;
    }
    __syncthreads();
}
__device__ __forceinline__ void moe_tables(Frame& F, const unsigned* moetab) {
    LAS int* tstart = (LAS int*)(F.misc + MI_TSTART); LAS int* ecnt = (LAS int*)(F.misc + MI_ECNT); LAS int* estart = (LAS int*)(F.misc + MI_ESTART);
    __syncthreads();
    if (F.tid < 32) { ecnt[F.tid] = (int)moetab[F.tid]; estart[F.tid] = (int)moetab[32 + F.tid]; }
    __syncthreads();
    if (F.tid == 0) { int acc = 0; for (int e = 0; e < 32; ++e) { tstart[e] = acc; acc += (ecnt[e] + 255) >> 8; } tstart[32] = acc; }
    __syncthreads();
}

__device__ __forceinline__ void spatial_phase(Frame& F, int nchunks, const float* w_s  , const float* b_s  , const float* g_v  ,
                                              const bf16* VT, const float* vssq, const bf16* U, bf16* Z) {
    LAS float* rs = (LAS float*)(F.misc + MI_SCR);
    const int fr = F.lane & 15, fq = F.lane >> 4;
    for (int ui = F.vcu; ui < nchunks * 8; ui += F.G) {
        const int chunk = ui >> 3, g = ui & 7;
        __syncthreads();
        if (F.tid < 128) { const int tok = chunk * 128 + F.tid; float s = 0.f;
#pragma unroll
            for (int i = 0; i < 8; ++i) s += vssq[(size_t)i * TT + tok];
            rs[F.tid] = 1.0f / sqrtf(s * (1.0f / 1024.0f) + EPS); }
        __syncthreads();
        const int p = 16 * F.wave + fr;
        f32x4 acc[8];
#pragma unroll
        for (int n = 0; n < 8; ++n) acc[n] = (f32x4){0.f, 0.f, 0.f, 0.f};
        const float* wrow = w_s + ((size_t)g * 128 + p) * 128;
#pragma unroll
        for (int kk = 0; kk < 4; ++kk) { const int q0 = 32 * kk + 8 * fq;
            const f32x4 w0 = *(const f32x4*)(wrow + q0), w1 = *(const f32x4*)(wrow + q0 + 4);
            const f32x4 r0 = *(const LAS f32x4*)(rs + q0), r1 = *(const LAS f32x4*)(rs + q0 + 4);
            u32x4 aw; aw.x = pk2(w0[0] * r0[0], w0[1] * r0[1]); aw.y = pk2(w0[2] * r0[2], w0[3] * r0[3]); aw.z = pk2(w1[0] * r1[0], w1[1] * r1[1]); aw.w = pk2(w1[2] * r1[2], w1[3] * r1[3]);
            const bf16x8 af = __builtin_bit_cast(bf16x8, aw);
#pragma unroll
            for (int n = 0; n < 8; ++n) { const bf16x8 bf = *(const bf16x8*)(VT + (size_t)(g * 128 + 16 * n + fr) * TT + chunk * 128 + q0);
                acc[n] = __builtin_amdgcn_mfma_f32_16x16x32_bf16(bf, af, acc[n], 0, 0, 0); } }
        const int tok = chunk * 128 + p; const float bs = b_s[g * 128 + p];
#pragma unroll
        for (int n = 0; n < 8; ++n) { const int c0 = g * 128 + 16 * n + 4 * fq; const f32x4 gv = *(const f32x4*)(g_v + c0);
            const u32x2 uu = *(const u32x2*)(U + (size_t)tok * D + c0);
            const float z0 = bf2f(uu.x & 0xffffu) * (acc[n][0] * gv[0] + bs), z1 = bf2f(uu.x >> 16) * (acc[n][1] * gv[1] + bs), z2 = bf2f(uu.y & 0xffffu) * (acc[n][2] * gv[2] + bs), z3 = bf2f(uu.y >> 16) * (acc[n][3] * gv[3] + bs);
            u32x2 o; o.x = pk2(z0, z1); o.y = pk2(z2, z3); *(u32x2*)(Z + (size_t)tok * D + c0) = o; }
    }
}

__device__ __forceinline__ void s5_scan_phase(Frame& F, const float* SBuf, bf16* XH, const float* A16) {
    for (int it = F.wave * F.G + F.vcu; it < NB * S5G * 2; it += F.G * NWAVES) {
        const int b = it & 7, g = (it >> 3) & 63, dir = it >> 9, p = F.lane;
        const float ar = A16[((size_t)(g * 2 + dir) * 2) * 64 + p], ai = A16[((size_t)(g * 2 + dir) * 2 + 1) * 64 + p];
        float hr = 0.f, hi = 0.f;
        for (int i0 = 0; i0 < 144; i0 += 8) {
            float sr[8], si[8]; int rix[8];
#pragma unroll
            for (int j = 0; j < 8; ++j) { const int i = i0 + j; int r;
                if (dir == 0) r = i < 16 ? (1024 + b * 16 + i) : (b * 128 + (i - 16)); else r = i < 16 ? (1024 + b * 16 + (15 - i)) : (b * 128 + (127 - (i - 16)));
                rix[j] = r; const float* sp = SBuf + ((size_t)g * S5PAD + r) * 256 + dir * 128 + p; sr[j] = sp[0]; si[j] = sp[64]; }
#pragma unroll
            for (int j = 0; j < 8; ++j) { bf16* hp = XH + ((size_t)g * S5PAD + rix[j]) * 512 + 256 + dir * 128 + p;
                hp[0] = (bf16)f2bf(hr); hp[64] = (bf16)f2bf(hi);
                const float nr = ar * hr - ai * hi + sr[j], ni = ar * hi + ai * hr + si[j]; hr = nr; hi = ni; }
        }
    }
}

__device__ __forceinline__ void qk_finalize_phase(Frame& F, const bf16* QR, const bf16* ZL, bf16* QF, bf16* KF, const float* g_qn, const float* g_kn) {
    const int gw = F.vcu * NWAVES + F.wave, NGW = F.G * NWAVES, l = F.lane;
    const float gq0 = g_qn[2 * l], gq1 = g_qn[2 * l + 1], gq2 = g_qn[128 + l], gk0 = g_kn[2 * l], gk1 = g_kn[2 * l + 1], gk2 = g_kn[128 + l];
    const int ax = l >> 5, fi = l & 15, half = (l >> 4) & 1;
    const float invf = __builtin_amdgcn_exp2f(-(float)fi * (13.287712379549449f / 16.0f));
    for (int row = gw; row < TT; row += NGW) {
        const bool lat = row < TL; const int b = lat ? (row >> 11) : ((row - TL) >> 8), s = lat ? (row & 2047) : ((row - TL) & 255), key = lat ? (CTXL + s) : s;
        float cs = 1.0f, sn = 0.0f;
        if (lat) { const float pos = (float)(ax == 0 ? (s >> 6) : (s & 63)); sincosf(pos * invf, &sn, &cs); }
        const float kpe = bf2f(ZL[(size_t)row * 768 + 640 + l]);
        const float kss = wave_sum(kpe * kpe);
#pragma unroll 1
        for (int h = 0; h < NH; ++h) {
            const size_t o = ((size_t)(b * NH + h) * KEYS + key) * DQK;
            {
                const bf16* qp = QR + (size_t)row * 1536 + h * 192; const unsigned qn = *(const unsigned*)(qp + 2 * l); float x0 = bf2f(qn & 0xffffu), x1 = bf2f(qn >> 16), x2 = bf2f(qp[128 + l]);
                const float rstd = 1.0f / sqrtf(wave_sum(x0 * x0 + x1 * x1 + x2 * x2) * (1.0f / 192.0f) + EPS);
                x0 *= rstd * gq0; x1 *= rstd * gq1; x2 *= rstd * gq2;
                const float pr = __shfl_xor(x2, 16); const float xr = half == 0 ? (x2 * cs - pr * sn) : (x2 * cs + pr * sn);
                *(unsigned*)(QF + o + 2 * l) = pk2(x0, x1); QF[o + 128 + l] = (bf16)f2bf(xr);
            }
            {
                const unsigned kn = *(const unsigned*)(KF + o + 2 * l); float x0 = bf2f(kn & 0xffffu), x1 = bf2f(kn >> 16), x2 = kpe;
                const float rstd = 1.0f / sqrtf((wave_sum(x0 * x0 + x1 * x1) + kss) * (1.0f / 192.0f) + EPS);
                x0 *= rstd * gk0; x1 *= rstd * gk1; x2 *= rstd * gk2;
                const float pr = __shfl_xor(x2, 16); const float xr = half == 0 ? (x2 * cs - pr * sn) : (x2 * cs + pr * sn);
                *(unsigned*)(KF + o + 2 * l) = pk2(x0, x1); KF[o + 128 + l] = (bf16)f2bf(xr);
            }
        }
    }
}

__device__ __forceinline__ void final_phase(Frame& F, const float* Hbuf, const float* modprev, const bf16* Y, const int* tokslot, float* out) {
    const int gw = F.vcu * NWAVES + F.wave, NGW = F.G * NWAVES;
    for (int row = gw; row < TL; row += NGW) {
        const int b = row >> 11; const f32x4* hrow = (const f32x4*)(Hbuf + (size_t)row * D); const f32x4* g5 = (const f32x4*)(modprev + (size_t)b * 6144 + 5120);
        f32x4 ys[4];
#pragma unroll
        for (int j = 0; j < 4; ++j) ys[j] = (f32x4){0.f, 0.f, 0.f, 0.f};
#pragma unroll
        for (int k = 0; k < 4; ++k) { const int slot = tokslot[row * 4 + k]; const u32x2* yr = (const u32x2*)(Y + (size_t)slot * D);
#pragma unroll
            for (int j = 0; j < 4; ++j) { const u32x2 y = yr[F.lane + 64 * j]; ys[j] += (f32x4){bf2f(y.x & 0xffffu), bf2f(y.x >> 16), bf2f(y.y & 0xffffu), bf2f(y.y >> 16)}; } }
        f32x4* orow = (f32x4*)(out + (size_t)row * D);
#pragma unroll
        for (int j = 0; j < 4; ++j) orow[F.lane + 64 * j] = hrow[F.lane + 64 * j] + g5[F.lane + 64 * j] * ys[j];
    }
}

namespace att {
constexpr int NWv = 8, QBLK = 32, KVBLK = 64;
constexpr float SCALE = 0.07216878364870322f;
constexpr float THR = 8.f;
constexpr int SHM_V = KVBLK * DV * 2, SHM_K = KVBLK * DQK * 2;
constexpr int LDS_ATT = 2 * SHM_V + 2 * SHM_K + NWv * 64 * 4;
#define KSWZ(row, colB) ((row) * 384 + ((colB) ^ ((((row) >> 1) & 7) << 4)))
#define SBAR() __builtin_amdgcn_sched_barrier(0)
__device__ __forceinline__ int crow(int r, int hi) { return (r & 3) + 8 * (r >> 2) + 4 * hi; }
__device__ __forceinline__ void partialSM(f32x16& p0, f32x16& p1, float& m_reg, float& mn, float& alpha) {
  constexpr float C = SCALE * 1.4426950408889634f;
  float pmax = p0[0];
#pragma unroll
  for (int r = 1; r < 16; ++r) pmax = fmaxf(pmax, p0[r]);
#pragma unroll
  for (int r = 0; r < 16; ++r) pmax = fmaxf(pmax, p1[r]);
  { auto rr = __builtin_amdgcn_permlane32_swap(__float_as_uint(pmax), __float_as_uint(pmax), false, false);
    pmax = fmaxf(__uint_as_float(rr[0]), __uint_as_float(rr[1])); }
  if (__builtin_expect(__all(pmax - m_reg <= THR / SCALE), 1)) { mn = m_reg; alpha = 1.f; }
  else { mn = fmaxf(m_reg, pmax); alpha = __builtin_amdgcn_exp2f((m_reg - mn) * C); m_reg = mn; }
  const float mnC = -mn * C;
#pragma unroll
  for (int r = 0; r < 16; ++r) p0[r] = fmaf(p0[r], C, mnC);
#pragma unroll
  for (int r = 0; r < 16; ++r) p1[r] = fmaf(p1[r], C, mnC);
#pragma unroll
  for (int r = 0; r < 16; ++r) p0[r] = __builtin_amdgcn_exp2f(p0[r]);
}
__device__ __forceinline__ void finishSM(f32x16& p0, f32x16& p1, float alpha, float& l_reg, bf16x8& pa0, bf16x8& pa1, bf16x8& pa2, bf16x8& pa3) {
#pragma unroll
  for (int r = 0; r < 16; ++r) p1[r] = __builtin_amdgcn_exp2f(p1[r]);
  float ps = 0;
#pragma unroll
  for (int r = 0; r < 16; ++r) ps += p0[r];
#pragma unroll
  for (int r = 0; r < 16; ++r) ps += p1[r];
  { auto rr = __builtin_amdgcn_permlane32_swap(__float_as_uint(ps), __float_as_uint(ps), false, false);
    ps = __uint_as_float(rr[0]) + __uint_as_float(rr[1]); }
  l_reg = l_reg * alpha + ps;
#define PK4(P, BASE, OUT) do { unsigned a0 = cvt_pk_bf16(P[BASE + 0], P[BASE + 1]), a1 = cvt_pk_bf16(P[BASE + 2], P[BASE + 3]);   \
    unsigned b0 = cvt_pk_bf16(P[BASE + 4], P[BASE + 5]), b1 = cvt_pk_bf16(P[BASE + 6], P[BASE + 7]);                              \
    auto r0 = __builtin_amdgcn_permlane32_swap(a0, b0, false, false); auto r1 = __builtin_amdgcn_permlane32_swap(a1, b1, false, false); \
    u32x4 w = {r0[0], r1[0], r0[1], r1[1]}; OUT = __builtin_bit_cast(bf16x8, w); } while (0)
  PK4(p0, 0, pa0); PK4(p0, 8, pa1); PK4(p1, 0, pa2); PK4(p1, 8, pa3);
#undef PK4
}
__device__ __forceinline__ void qkt(f32x16& p0, f32x16& p1, const char* Ks, const bf16x8* qr, int r32, int hi) {
  p0 = f32x16{}; p1 = f32x16{};
#pragma unroll
  for (int d0 = 0; d0 < 12; ++d0) { const int cb = (d0 * 16 + hi * 8) * 2;
    const bf16x8 b0 = *reinterpret_cast<const bf16x8*>(Ks + KSWZ(r32, cb));
    const bf16x8 b1 = *reinterpret_cast<const bf16x8*>(Ks + KSWZ(32 + r32, cb));
    p0 = __builtin_amdgcn_mfma_f32_32x32x16_bf16(b0, qr[d0], p0, 0, 0, 0);
    p1 = __builtin_amdgcn_mfma_f32_32x32x16_bf16(b1, qr[d0], p1, 0, 0, 0); }
}
__device__ __forceinline__ int v_st(int k, int c) { const int kk = (k & ~0xC) | ((k & 4) << 1) | ((k & 8) >> 1); return ((kk >> 3) * 4 + (c >> 5)) * 512 + ((kk & 7) * 32 + (c & 31)) * 2; }
__device__ __forceinline__ int v_rd_base(int lane) { return ((lane & 3) << 3) | (((lane >> 2) & 3) << 6) | (((lane >> 4) & 1) << 5) | (((lane >> 5) & 1) << 8); }
constexpr int v_rd_off(int d0, int ks, int half) { return d0 * 512 + ks * 4096 + half * 2048; }
template <int OFF> __device__ __forceinline__ s16x4 tr_read(int vb) {
  s16x4 r; asm volatile("ds_read_b64_tr_b16 %0, %1 offset:%2" : "=&v"(r) : "v"(vb), "i"(OFF) : "memory"); return r;
}
template <int D0> __device__ __forceinline__ void pv_one(f32x16& od, int vb, bf16x8 pa0, bf16x8 pa1, bf16x8 pa2, bf16x8 pa3) {
  const s16x4 l0 = tr_read<v_rd_off(D0, 0, 0)>(vb), h0 = tr_read<v_rd_off(D0, 0, 1)>(vb), l1 = tr_read<v_rd_off(D0, 1, 0)>(vb), h1 = tr_read<v_rd_off(D0, 1, 1)>(vb);
  const s16x4 l2 = tr_read<v_rd_off(D0, 2, 0)>(vb), h2 = tr_read<v_rd_off(D0, 2, 1)>(vb), l3 = tr_read<v_rd_off(D0, 3, 0)>(vb), h3 = tr_read<v_rd_off(D0, 3, 1)>(vb);
  asm volatile("s_waitcnt lgkmcnt(0)" ::: "memory"); SBAR();
#define PK(L, H) (bf16x8){L[0], L[1], L[2], L[3], H[0], H[1], H[2], H[3]}
  od = __builtin_amdgcn_mfma_f32_32x32x16_bf16(pa0, PK(l0, h0), od, 0, 0, 0);
  od = __builtin_amdgcn_mfma_f32_32x32x16_bf16(pa1, PK(l1, h1), od, 0, 0, 0);
  od = __builtin_amdgcn_mfma_f32_32x32x16_bf16(pa2, PK(l2, h2), od, 0, 0, 0);
  od = __builtin_amdgcn_mfma_f32_32x32x16_bf16(pa3, PK(l3, h3), od, 0, 0, 0);
#undef PK
}
__device__ __forceinline__ void pv_d0(f32x16* o, int vb, bf16x8 pa0, bf16x8 pa1, bf16x8 pa2, bf16x8 pa3) {
  pv_one<0>(o[0], vb, pa0, pa1, pa2, pa3); pv_one<1>(o[1], vb, pa0, pa1, pa2, pa3); pv_one<2>(o[2], vb, pa0, pa1, pa2, pa3); pv_one<3>(o[3], vb, pa0, pa1, pa2, pa3);
}
__device__ __forceinline__ void attn_unit(const bf16* __restrict__ Qb, const bf16* __restrict__ Kh, const bf16* __restrict__ Vh, bf16* __restrict__ Ob, int seq, char* lds) {
  const int tid = threadIdx.x, wid = tid >> 6, lane = tid & 63, r32 = lane & 31, hi = lane >> 5;
  char* V_lds = lds; char* K_lds = lds + 2 * SHM_V;
  float* wsp = (float*)(lds + 2 * SHM_V + 2 * SHM_K) + wid * 64; float* li_l = wsp; float* al_l = wsp + 32;
  float m_reg = -1e30f, l_reg = 0; f32x16 o[4] = {}; bf16x8 qr[12];
  const bf16* Qw = Qb + (long)(wid * QBLK + r32) * DQK + hi * 8;
#pragma unroll
  for (int d0 = 0; d0 < 12; ++d0) qr[d0] = *reinterpret_cast<const bf16x8*>(Qw + d0 * 16);
  const int sr = tid >> 4, sc = (tid & 15) * 8, vst0 = v_st(sr, sc), vst1 = v_st(32 + sr, sc);
  int krow[3], kch[3];
#pragma unroll
  for (int i = 0; i < 3; ++i) { const int q = tid + 512 * i; krow[i] = q / 24; kch[i] = q % 24; }
  const int vb0 = (int)(uintptr_t)V_lds + v_rd_base(lane);
  bf16x8 vs0, vs1, ks0, ks1, ks2;
#define SLOAD(k0) do { vs0 = *reinterpret_cast<const bf16x8*>(&Vh[(long)((k0) + sr) * DV + sc]); vs1 = *reinterpret_cast<const bf16x8*>(&Vh[(long)((k0) + 32 + sr) * DV + sc]); \
    ks0 = *reinterpret_cast<const bf16x8*>(&Kh[(long)((k0) + krow[0]) * DQK + kch[0] * 8]); ks1 = *reinterpret_cast<const bf16x8*>(&Kh[(long)((k0) + krow[1]) * DQK + kch[1] * 8]); \
    ks2 = *reinterpret_cast<const bf16x8*>(&Kh[(long)((k0) + krow[2]) * DQK + kch[2] * 8]); } while (0)
#define SWRITE(b) do { *(bf16x8*)(V_lds + (b) * SHM_V + vst0) = vs0; *(bf16x8*)(V_lds + (b) * SHM_V + vst1) = vs1; \
    *(bf16x8*)(K_lds + (b) * SHM_K + KSWZ(krow[0], kch[0] * 16)) = ks0; *(bf16x8*)(K_lds + (b) * SHM_K + KSWZ(krow[1], kch[1] * 16)) = ks1; \
    *(bf16x8*)(K_lds + (b) * SHM_K + KSWZ(krow[2], kch[2] * 16)) = ks2; } while (0)
#define SWAIT() asm volatile("s_waitcnt vmcnt(0)" ::: "memory")
#define RESC(a) do { if (__any((a) < 1.f)) { if (hi == 0) al_l[r32] = (a); asm volatile("s_waitcnt lgkmcnt(0)" ::: "memory"); \
    _Pragma("unroll") for (int d = 0; d < 4; ++d) _Pragma("unroll") for (int r = 0; r < 16; ++r) o[d][r] *= al_l[crow(r, hi)]; } } while (0)
  f32x16 p0, p1; float mn, al; bf16x8 pa0, pa1, pa2, pa3; const int NT = seq / KVBLK;
  SLOAD(0); SWAIT(); SWRITE(0); __syncthreads();
  for (int j = 0; j < NT; ++j) {
    const int buf = j & 1; const bool more = (j + 1 < NT);
    if (more) SLOAD((j + 1) * KVBLK);
    SBAR(); qkt(p0, p1, K_lds + buf * SHM_K, qr, r32, hi);
    partialSM(p0, p1, m_reg, mn, al);
    RESC(al);
    finishSM(p0, p1, al, l_reg, pa0, pa1, pa2, pa3); SBAR();
    pv_d0(o, vb0 + buf * SHM_V, pa0, pa1, pa2, pa3);
    if (more) { SWAIT(); SWRITE(buf ^ 1); }
    __syncthreads();
  }
  if (hi == 0) li_l[r32] = l_reg; asm volatile("s_waitcnt lgkmcnt(0)" ::: "memory");
  float rli[16];
#pragma unroll
  for (int r = 0; r < 16; ++r) rli[r] = __builtin_amdgcn_rcpf(li_l[crow(r, hi)]);
  bf16* Ow = Ob + (long)(wid * QBLK) * D;
#pragma unroll
  for (int r = 0; r < 16; ++r) { const int orow = crow(r, hi);
#pragma unroll
    for (int d0 = 0; d0 < 4; ++d0) Ow[(long)orow * D + d0 * 32 + r32] = (bf16)f2bf(o[d0][r] * rli[r]); }
#undef SLOAD
#undef SWRITE
#undef SWAIT
#undef RESC
}
#undef KSWZ
}

__device__ __forceinline__ void attn_phase(Frame& F, const bf16* QF, const bf16* KF, const bf16* VF, bf16* O, char* lds) {
    for (int ui = F.vcu; ui < 576; ui += F.G) {
        int bh, qrow0, seq; long orow0;
        if (ui < 512) { bh = ui >> 3; const int qb = ui & 7; qrow0 = CTXL + qb * 256; seq = KEYS; orow0 = (long)(bh >> 3) * SEQ + qb * 256; }
        else { bh = ui - 512; qrow0 = 0; seq = CTXL; orow0 = (long)TL + (long)(bh >> 3) * CTXL; }
        __syncthreads();
        att::attn_unit(QF + ((size_t)bh * KEYS + qrow0) * DQK, KF + (size_t)bh * KEYS * DQK, VF + (size_t)bh * KEYS * DV, O + (size_t)orow0 * D + (bh & 7) * DV, seq, lds);
    }
    __syncthreads();
}

#ifndef MK_ONE_LAUNCH
#define MK_ONE_LAUNCH 0
#endif
constexpr int NPHASES = 38;
struct Args { const float* in[39]; float* out; unsigned char* ws; int ph_lo, ph_hi; };

__global__ void __launch_bounds__(NTHREADS, 2) fwd(Args args) {
    extern __shared__ __attribute__((aligned(16))) unsigned char lds[];
    Frame F;
    F.lds = (LAS unsigned char*)lds; F.misc = F.lds + MISC_OFF;
    F.tid = threadIdx.x; F.lane = F.tid & 63; F.wave = __builtin_amdgcn_readfirstlane(F.tid >> 6);
    F.G = gridDim.x; { const int bx = blockIdx.x; F.vcu = (F.G % 8 == 0) ? (bx % 8) * (F.G / 8) + bx / 8 : bx; }
    F.ws = args.ws; F.ctl = (unsigned*)(args.ws + WS_CTL); F.in = args.in;
    unsigned char* ws = args.ws; const float* const* in = args.in;
    if (F.tid < 16) ((LAS unsigned*)F.misc)[F.tid] = 0u;
    __syncthreads();
    XcdBarrier bar; bar.bar = F.ctl + CW_BAR; bar.x = 0; bar.st = nullptr;
    const int lo = args.ph_lo, hi = args.ph_hi;
    if (hi - lo > 1) bar = xcd_barrier_post(F.ctl + CW_BAR, (volatile LAS unsigned*)(F.misc + MI_BAR));
#ifndef PH_MIN
#define PH_MIN 0
#endif
#ifndef PH_MAX
#define PH_MAX 1000
#endif
#define IN(k) ((k) >= PH_MIN && (k) <= PH_MAX && lo <= (k) && (k) < hi)
#define SEAM(k) do { if (IN(k) && IN((k) + 1)) xcd_barrier(bar); } while (0)

    float* MOD = (float*)(ws + WS_MOD); float* H = (float*)(ws + WS_H);
    bf16* NBf = (bf16*)(ws + WS_NB); bf16* UB = (bf16*)(ws + WS_UB); bf16* VT = (bf16*)(ws + WS_VT); bf16* ZB = (bf16*)(ws + WS_ZB);
    bf16* XH = (bf16*)(ws + WS_XH); float* SBf = (float*)(ws + WS_SB); bf16* ZL = (bf16*)(ws + WS_ZL); bf16* QR = (bf16*)(ws + WS_QR);
    bf16* QF = (bf16*)(ws + WS_QF); bf16* KF = (bf16*)(ws + WS_KF); bf16* VF = (bf16*)(ws + WS_VF); bf16* ACT = (bf16*)(ws + WS_ACT); bf16* YB = (bf16*)(ws + WS_YB);
    int* TOPE = (int*)(ws + WS_TOPE); float* TOPG = (float*)(ws + WS_TOPG); int* TOKSLOT = (int*)(ws + WS_TOKSLOT); int* SLOTTOK = (int*)(ws + WS_SLOTTOK); float* SLOTGATE = (float*)(ws + WS_SLOTGATE);
    float* VSSQ = (float*)(ws + WS_VSSQ); float* MLASSQ = (float*)(ws + WS_MLASSQ);
    LAS unsigned char* ring = F.lds;

    if (IN(0)) { p0_prologue(F); } SEAM(0);

#define MOE_BLOCK(L, PB, NR) \
    if (IN(PB)) { norm_phase<false, true>(F, NR, in[7] + (L) * 1024, MOD + (size_t)(L) * 9 * 6144, 3072, 4096, nullptr, nullptr, nullptr, H, NBf, \
                      (const float*)(ws + WS_WRT) + (size_t)(L) * 32768, in[32] + (L) * 32, TOPE, TOPG, F.ctl + CW_HIST + ((L) * 256 + F.vcu) * 32); } SEAM(PB); \
    if (IN((PB) + 1)) { dispatch_phase(F, NR, F.ctl + CW_HIST + (L) * 256 * 32, F.ctl + CW_MOE + (L) * 128, TOPE, TOPG, TOKSLOT, SLOTTOK, SLOTGATE); } SEAM((PB) + 1); \
    if (IN((PB) + 2)) { moe_tables(F, F.ctl + CW_MOE + (L) * 128); \
        MoeSched S{(const LAS int*)(F.misc + MI_TSTART), (const LAS int*)(F.misc + MI_ECNT), (const LAS int*)(F.misc + MI_ESTART), 8, F.G, (int)blockIdx.x}; \
        MoeUpOps O{(const char*)NBf, (const char*)(ws + WS_WGU) + (size_t)(L) * 32 * 2048 * 1024 * 2, SLOTTOK, 1024, 1024, 1024}; \
        EpiMoeUp E{ACT, in[34] + (size_t)(L) * 32 * 1024, in[36] + (size_t)(L) * 32 * 1024}; \
        pg::gemm_phase(ring, O, S, E); } SEAM((PB) + 2); \
    if (IN((PB) + 3)) { moe_tables(F, F.ctl + CW_MOE + (L) * 128); \
        MoeSched S{(const LAS int*)(F.misc + MI_TSTART), (const LAS int*)(F.misc + MI_ECNT), (const LAS int*)(F.misc + MI_ESTART), 4, F.G, (int)blockIdx.x}; \
        MoeDownOps O{(const char*)ACT, (const char*)(ws + WS_WD) + (size_t)(L) * 32 * 1024 * 1024 * 2, 1024, 1024, 1024}; \
        EpiMoeDown E{YB, in[38] + (size_t)(L) * 32 * 1024, SLOTGATE}; \
        pg::gemm_phase(ring, O, S, E); } SEAM((PB) + 3);

#define GMLP_BLOCK(L, SL, PB, NR) \
    if (IN((PB) + 1)) { \
        { DenseOps O{(const char*)NBf, (const char*)(ws + WS_WSGIN) + (size_t)(SL) * 2048 * 1024 * 2, 1024, 1024, 1024}; DenseSched S; S.init(NR, 1024, F.G, (int)blockIdx.x); EpiBf16Gelu E{UB, 1024}; pg::gemm_phase(ring, O, S, E); } \
        { DenseOps O{(const char*)(ws + WS_WSGIN) + ((size_t)(SL) * 2048 + 1024) * 1024 * 2, (const char*)NBf, 1024, 1024, 1024}; DenseSched S; S.init(1024, NR, F.G, (int)blockIdx.x); EpiVT E{VT, TT, VSSQ, TT}; pg::gemm_phase(ring, O, S, E); } \
    } SEAM((PB) + 1); \
    if (IN((PB) + 2)) { spatial_phase(F, (NR) / 128, in[10] + (size_t)(SL) * 8 * 128 * 128, in[11] + (size_t)(SL) * 8 * 128, in[9] + (size_t)(SL) * 1024, VT, VSSQ, UB, ZB); } SEAM((PB) + 2); \
    if (IN((PB) + 3)) { DenseOps O{(const char*)ZB, (const char*)(ws + WS_WSGOUT) + (size_t)(SL) * 1024 * 1024 * 2, 1024, 1024, 1024}; DenseSched S; S.init(NR, 1024, F.G, (int)blockIdx.x); \
        EpiResid E{H, MOD + (size_t)(L) * 9 * 6144, 2048}; pg::gemm_phase(ring, O, S, E); } SEAM((PB) + 3);

    if (IN(1)) { norm_phase<false, false>(F, TT, in[6] + 0 * 1024, MOD + (size_t)0 * 9 * 6144, 0, 1024, nullptr, nullptr, nullptr, H, NBf, nullptr, nullptr, nullptr, nullptr, nullptr); } SEAM(1);
    GMLP_BLOCK(0, 0, 1, TT)
    MOE_BLOCK(0, 5, TT)

    if (IN(9)) { norm_phase<true, false>(F, TT, in[6] + 1 * 1024, MOD + (size_t)1 * 9 * 6144, 0, 1024, MOD + (size_t)0 * 9 * 6144, YB, TOKSLOT, H, NBf, nullptr, nullptr, nullptr, nullptr, nullptr); } SEAM(9);
    if (IN(10)) { DenseOps O{(const char*)NBf, (const char*)(ws + WS_WSSMIN), 1024, 1024, 1024}; DenseSched S; S.init(TT, 1024, F.G, (int)blockIdx.x); EpiS5In E{XH}; pg::gemm_phase(ring, O, S, E); } SEAM(10);
    if (IN(11)) { S5Ops O{(const char*)XH, (const char*)(ws + WS_GT), 256, 512, 256}; S5Sched S{F.G, (int)blockIdx.x}; EpiS5State E{SBf}; pg::gemm_phase(ring, O, S, E); } SEAM(11);
    if (IN(12)) { s5_scan_phase(F, SBf, XH, (const float*)(ws + WS_A16)); } SEAM(12);
    if (IN(13)) { S5Ops O{(const char*)XH, (const char*)(ws + WS_TET), 512, 512, 512}; S5Sched S{F.G, (int)blockIdx.x}; EpiS5Out E{ZB}; pg::gemm_phase(ring, O, S, E); } SEAM(13);
    if (IN(14)) { DenseOps O{(const char*)ZB, (const char*)(ws + WS_WGLU), 1024, 1024, 1024}; DenseSched S; S.init(TT, 2048, F.G, (int)blockIdx.x); EpiGlu E{H, MOD + (size_t)1 * 9 * 6144, 2048}; pg::gemm_phase(ring, O, S, E); } SEAM(14);
    MOE_BLOCK(1, 15, TT)

    if (IN(19)) { norm_phase<true, false>(F, TT, in[6] + 2 * 1024, MOD + (size_t)2 * 9 * 6144, 0, 1024, MOD + (size_t)1 * 9 * 6144, YB, TOKSLOT, H, NBf, nullptr, nullptr, nullptr, nullptr, nullptr); } SEAM(19);
    if (IN(20)) { DenseOps O{(const char*)NBf, (const char*)(ws + WS_WMLAIN), 1024, 1024, 1024}; DenseSched S; S.init(TT, 768, F.G, (int)blockIdx.x); EpiMlaIn E{ZL, MLASSQ}; pg::gemm_phase(ring, O, S, E); } SEAM(20);
    if (IN(21)) {
        { DenseOps O{(const char*)ZL, (const char*)(ws + WS_WUQ), 384, 768, 384}; DenseSched S; S.init(TT, 1536, F.G, (int)blockIdx.x); EpiMlaUp<0> E{QR, nullptr, MLASSQ, 0, 12, 1.0f / 384.0f}; pg::gemm_phase(ring, O, S, E); }
        { DenseOps O{(const char*)(ZL + 384), (const char*)(ws + WS_WUKV), 256, 768, 256}; DenseSched S; S.init(TT, 2048, F.G, (int)blockIdx.x); EpiMlaUp<1> E{KF, VF, MLASSQ, 12, 8, 1.0f / 256.0f}; pg::gemm_phase(ring, O, S, E); }
    } SEAM(21);
    if (IN(22)) { qk_finalize_phase(F, QR, ZL, QF, KF, in[28], in[29]); } SEAM(22);
    if (IN(23)) { attn_phase(F, QF, KF, VF, ZB, (char*)lds); } SEAM(23);
    if (IN(24)) { DenseOps O{(const char*)ZB, (const char*)(ws + WS_WMLAOUT), 1024, 1024, 1024}; DenseSched S; S.init(TT, 1024, F.G, (int)blockIdx.x); EpiResid E{H, MOD + (size_t)2 * 9 * 6144, 2048}; pg::gemm_phase(ring, O, S, E); } SEAM(24);
    MOE_BLOCK(2, 25, TT)

    if (IN(29)) { norm_phase<true, false>(F, TL, in[6] + 3 * 1024, MOD + (size_t)3 * 9 * 6144, 0, 1024, MOD + (size_t)2 * 9 * 6144, YB, TOKSLOT, H, NBf, nullptr, nullptr, nullptr, nullptr, nullptr); } SEAM(29);
    GMLP_BLOCK(3, 1, 29, TL)
    MOE_BLOCK(3, 33, TL)

    if (IN(37)) { final_phase(F, H, MOD + (size_t)3 * 9 * 6144, YB, TOKSLOT, args.out); }
#undef IN
#undef SEAM
}

extern "C" void kernel_launch(void* const* d_in, const int* in_sizes, int n_in, void* d_out, int out_size, void* d_ws, size_t ws_size, hipStream_t stream) {
    static int grid = 0;
    if (grid == 0) {
        if (n_in != 39 || out_size != TL * D || ws_size < WS_END) { fprintf(stderr, "kernel_launch: built for 39 inputs, out %d floats, >= %zu bytes of workspace; got n_in %d, out %d, ws %zu; nothing launched\n", TL * D, (size_t)WS_END, n_in, out_size, ws_size); grid = -1; return; }
        int dev = 0, cus = 0, per_cu = 0;
        if (hipGetDevice(&dev) != hipSuccess || hipDeviceGetAttribute(&cus, hipDeviceAttributeMultiprocessorCount, dev) != hipSuccess) { fprintf(stderr, "kernel_launch: device query failed\n"); grid = -1; return; }
        if (hipFuncSetAttribute((const void*)fwd, hipFuncAttributeMaxDynamicSharedMemorySize, LDS_BYTES) != hipSuccess) { fprintf(stderr, "kernel_launch: hipFuncSetAttribute failed\n"); grid = -1; return; }
        if (hipOccupancyMaxActiveBlocksPerMultiprocessor(&per_cu, (const void*)fwd, NTHREADS, LDS_BYTES) != hipSuccess || per_cu < 1) fprintf(stderr, "kernel_launch: note: occupancy query reports %d workgroups per CU\n", per_cu);
        (void)hipGetLastError();
        grid = cus;
        if (grid != 256) fprintf(stderr, "kernel_launch: warning: %d CUs; the row-to-workgroup deal assumes 256\n", grid);
    }
    if (grid < 0) return;
    if (hipMemsetAsync((char*)d_ws + WS_CTL, 0, CTL_ZERO_BYTES, stream) != hipSuccess) { fprintf(stderr, "kernel_launch: memset failed\n"); return; }
    Args a{};
    for (int i = 0; i < 39; ++i) a.in[i] = (const float*)d_in[i];
    a.out = (float*)d_out; a.ws = (unsigned char*)d_ws;
#if MK_ONE_LAUNCH
    a.ph_lo = 0; a.ph_hi = NPHASES;
    hipLaunchKernelGGL(fwd, dim3(grid), dim3(NTHREADS), LDS_BYTES, stream, a);
#else
    for (int p = 0; p < NPHASES; ++p) { a.ph_lo = p; a.ph_hi = p + 1; hipLaunchKernelGGL(fwd, dim3(grid), dim3(NTHREADS), LDS_BYTES, stream, a); }
#endif
    const hipError_t le = hipPeekAtLastError();
    if (le != hipSuccess) fprintf(stderr, "kernel_launch: launch failed: %s\n", hipGetErrorName(le));
}
```

```cpp
#include <hip/hip_runtime.h>
#include <cstdio>
#include <cstdint>
#include <cmath>

#define LAS __attribute__((address_space(3)))
#define GAS __attribute__((address_space(1)))
typedef unsigned short bf16;
typedef short bf16x8 __attribute__((ext_vector_type(8)));
typedef short s16x4 __attribute__((ext_vector_type(4)));
typedef float f32x4 __attribute__((ext_vector_type(4)));
typedef float f32x2 __attribute__((ext_vector_type(2)));
typedef float f32x16 __attribute__((ext_vector_type(16)));
typedef unsigned u32x4 __attribute__((ext_vector_type(4)));
typedef unsigned u32x2 __attribute__((ext_vector_type(2)));

constexpr int D = 1024, NB = 8, SEQ = 2048, CTXL = 256, DEPTH = 4;
constexpr int TL = NB * SEQ, TC = NB * CTXL, TT = TL + TC;
constexpr int NE = 32, TOPK = 4;
constexpr float EPS = 1e-6f;
constexpr int KEYS = CTXL + SEQ;
constexpr int DQK = 192, DV = 128, NH = 8;
constexpr int S5G = 64, S5ROWS = 1152, S5PAD = 1280;
constexpr int NWAVES = 8, NTHREADS = 512;

constexpr size_t MiB = 1u << 20;
constexpr size_t WS_CTL = 0, CTL_ZERO_BYTES = 1 * MiB;
constexpr size_t WS_MOD = 1 * MiB;
constexpr size_t WS_WSGIN = 2 * MiB;
constexpr size_t WS_WSGOUT = 10 * MiB;
constexpr size_t WS_WSSMIN = 14 * MiB;
constexpr size_t WS_WGLU = 16 * MiB;
constexpr size_t WS_WMLAIN = 20 * MiB;
constexpr size_t WS_WUQ = 22 * MiB;
constexpr size_t WS_WUKV = 24 * MiB;
constexpr size_t WS_WMLAOUT = 26 * MiB;
constexpr size_t WS_GT = 28 * MiB;
constexpr size_t WS_TET = 36 * MiB;
constexpr size_t WS_A16 = 52 * MiB;
constexpr size_t WS_SMALL = 53 * MiB;
constexpr size_t WS_TOPE = WS_SMALL;
constexpr size_t WS_TOPG = WS_TOPE + (size_t)TT * 16;
constexpr size_t WS_TOKSLOT = WS_TOPG + (size_t)TT * 16;
constexpr size_t WS_SLOTTOK = WS_TOKSLOT + (size_t)TT * 16;
constexpr size_t WS_SLOTGATE = WS_SLOTTOK + (size_t)74752 * 4;
constexpr size_t WS_VSSQ = WS_SLOTGATE + (size_t)74752 * 4;
constexpr size_t WS_MLASSQ = WS_VSSQ + (size_t)8 * TT * 4;
constexpr size_t WS_SMALL_END = WS_MLASSQ + (size_t)TT * 24 * 4;
static_assert(WS_SMALL_END <= 64 * MiB, "small arrays");
constexpr size_t WS_H = 64 * MiB;
constexpr size_t WS_NB = 136 * MiB;
constexpr size_t WS_UB = 172 * MiB;
constexpr size_t WS_VT = 208 * MiB;
constexpr size_t WS_ZB = 244 * MiB;
constexpr size_t WS_XH = 280 * MiB;
constexpr size_t WS_SB = 360 * MiB;
constexpr size_t WS_ZL = 440 * MiB;
constexpr size_t WS_QR = 468 * MiB;
constexpr size_t WS_QF = 522 * MiB;
constexpr size_t WS_KF = 576 * MiB;
constexpr size_t WS_VF = 630 * MiB;
constexpr size_t WS_ACT = 666 * MiB;
constexpr size_t WS_YB = 812 * MiB;
constexpr size_t WS_WGU = 960 * MiB;
constexpr size_t WS_WD = 1472 * MiB;
constexpr size_t WS_END = 1728 * MiB;
constexpr int CW_TMO = 0, CW_CODE = 1;
constexpr int CW_BAR = 4096;
constexpr int CW_HIST = 147456;
constexpr int CW_MOE = 196608;
static_assert((CW_MOE + 4 * 128) * 4 <= (int)CTL_ZERO_BYTES, "ctl");

constexpr int RING_BYTES = 131072;
constexpr int MISC_OFF = RING_BYTES;
constexpr int LDS_BYTES = 147456;
constexpr int MI_BAR = 0, MI_TSTART = 64, MI_ECNT = 256, MI_ESTART = 384, MI_HIST = 512, MI_SCR = 1024;

#define RLX_AGENT __ATOMIC_RELAXED, __HIP_MEMORY_SCOPE_AGENT
#define LDS_WAIT() asm volatile("s_waitcnt lgkmcnt(0)" ::: "memory")
#define VM_WAIT() asm volatile("s_waitcnt vmcnt(0)" ::: "memory")
__device__ __forceinline__ unsigned f2bf(float f) { unsigned u = __builtin_bit_cast(unsigned, f); return (u + 0x7fffu + ((u >> 16) & 1u)) >> 16; }
__device__ __forceinline__ unsigned pk2(float lo, float hi) { return f2bf(lo) | (f2bf(hi) << 16); }
__device__ __forceinline__ float bf2f(unsigned h) { return __builtin_bit_cast(float, h << 16); }
__device__ __forceinline__ unsigned cvt_pk_bf16(float lo, float hi) { unsigned r; asm volatile("v_cvt_pk_bf16_f32 %0, %1, %2" : "=v"(r) : "v"(lo), "v"(hi)); return r; }
__device__ __forceinline__ float wave_sum(float v) {
#pragma unroll
    for (int o = 1; o < 64; o <<= 1) v += __shfl_xor(v, o);
    return v;
}
__device__ __forceinline__ float wave_max(float v) {
#pragma unroll
    for (int o = 1; o < 64; o <<= 1) v = fmaxf(v, __shfl_xor(v, o));
    return v;
}
__device__ __forceinline__ f32x2 gelu_pk(f32x2 v) {
    const f32x2 av = __builtin_elementwise_abs(v), d = av * 0.2316418882f + 1.0f;
    f32x2 t; t.x = __builtin_amdgcn_rcpf(d.x); t.y = __builtin_amdgcn_rcpf(d.y);
    f32x2 q = t * 0.5307027145f + (-0.7265760135f); q = q * t + 0.7107068705f; q = q * t + (-0.142248368f); q = q * t + 0.127414796f; q = q * t;
    const f32x2 s = (v * v) * (-0.72134752044f);
    f32x2 e; e.x = __builtin_amdgcn_exp2f(s.x); e.y = __builtin_amdgcn_exp2f(s.y);
    const f32x2 m = v * (q * e), r = v - m;
    f32x2 o; o.x = v.x < 0.f ? m.x : r.x; o.y = v.y < 0.f ? m.y : r.y; return o;
}
__device__ __forceinline__ f32x4 gelu4(f32x4 v) { f32x2 a = gelu_pk((f32x2){v[0], v[1]}), b = gelu_pk((f32x2){v[2], v[3]}); return (f32x4){a.x, a.y, b.x, b.y}; }
__device__ __forceinline__ float sigmoidf_(float x) { return __builtin_amdgcn_rcpf(1.0f + __builtin_amdgcn_exp2f(-1.4426950408889634f * x)); }

#define XB_TMO      128
#define XB_XCNT(j)  (256  + 64 * (j))
#define XB_XSUB(j)  (1280 + 64 * (j))
#define XB_XGEN(j)  (2304 + 64 * (j))
#define XB_TOP      3328
#define XB_TOPGEN   3392
#define XCD_BAR_WORDS 3456
#define XB_SPIN_CAP (1u << 18)
__device__ __forceinline__ unsigned xb_ld(unsigned* p)              { return __hip_atomic_load(p, __ATOMIC_RELAXED, __HIP_MEMORY_SCOPE_AGENT); }
__device__ __forceinline__ unsigned xb_add(unsigned* p, unsigned v) { return __hip_atomic_fetch_add(p, v, __ATOMIC_RELAXED, __HIP_MEMORY_SCOPE_AGENT); }
__device__ __forceinline__ unsigned xb_xcc_id() { return (unsigned)__builtin_amdgcn_s_getreg((3 << 11) | 20) & 0xFu; }
#define XB_SPIN(cond, bar) do { unsigned _sp = 0; while (cond) { __builtin_amdgcn_s_sleep(1); \
    if ((++_sp & 255u) == 0u) { if (xb_ld(&(bar)[XB_TMO])) break; if (_sp > XB_SPIN_CAP) { atomicAdd(&(bar)[XB_TMO], 1u); break; } } } } while (0)
struct XcdBarrier { unsigned* bar; unsigned x; volatile LAS unsigned* st; };
__device__ __forceinline__ XcdBarrier xcd_barrier_post(unsigned* bar, volatile LAS unsigned* st) {
    XcdBarrier b; b.bar = bar; b.x = xb_xcc_id(); b.st = st;
    if (threadIdx.x == 0) (void)xb_add(&bar[XB_XCNT(b.x)], 1u);
    return b;
}
__device__ __forceinline__ void xcd_barrier_complete(unsigned* bar, unsigned x, unsigned& nloc, unsigned& nx) {
    const unsigned G = gridDim.x * gridDim.y * gridDim.z;
    unsigned sum, cnt, mine, sp = 0u;
    for (;;) {
        sum = 0u; cnt = 0u; mine = 0u;
#pragma unroll
        for (unsigned j = 0; j < 16; ++j) { const unsigned c = xb_ld(&bar[XB_XCNT(j)]); sum += c; cnt += (c > 0u) ? 1u : 0u; mine = (j == x) ? c : mine; }
        if (sum == G) break;
        __builtin_amdgcn_s_sleep(1);
        if ((++sp & 255u) == 0u) { if (xb_ld(&bar[XB_TMO])) break; if (sp > XB_SPIN_CAP) { atomicAdd(&bar[XB_TMO], 1u); break; } }
    }
    nloc = mine > 0u ? mine : 1u; nx = cnt > 0u ? cnt : 1u;
}
__device__ __forceinline__ void xcd_barrier(const XcdBarrier& b) {
    asm volatile("s_waitcnt vmcnt(0)" ::: "memory");
    __syncthreads();
    if (threadIdx.x == 0) {
        unsigned* bar = b.bar;
        __builtin_amdgcn_s_waitcnt(0);
        unsigned nloc = b.st[0], nx = b.st[1];
        if (nloc == 0u) { xcd_barrier_complete(bar, b.x, nloc, nx); b.st[0] = nloc; b.st[1] = nx; }
        const unsigned old = xb_add(&bar[XB_XSUB(b.x)], 1u);
        const unsigned gen = old / nloc;
        if (old + 1u == (gen + 1u) * nloc) {
            __builtin_amdgcn_fence(__ATOMIC_RELEASE, "agent");
            asm volatile("s_waitcnt vmcnt(0)" ::: "memory");
            const unsigned og = xb_add(&bar[XB_TOP], 1u);
            const unsigned tg = og / nx;
            if (og + 1u == (tg + 1u) * nx) xb_add(&bar[XB_TOPGEN], 1u);
            else XB_SPIN(xb_ld(&bar[XB_TOPGEN]) == tg, bar);
            __builtin_amdgcn_fence(__ATOMIC_ACQUIRE, "agent");
            xb_add(&bar[XB_XGEN(b.x)], 1u);
            asm volatile("s_waitcnt vmcnt(0)" ::: "memory");
        } else {
            XB_SPIN(xb_ld(&bar[XB_XGEN(b.x)]) == gen, bar);
            __builtin_amdgcn_fence(__ATOMIC_ACQUIRE, "agent");
            asm volatile("s_waitcnt vmcnt(0)" ::: "memory");
        }
    }
    __syncthreads();
}

namespace pg {
constexpr int BM = 256, BK = 64, HALF = 128, HTB = HALF * BK * 2, STAGE_BYTES = 8 * HTB, NXCD = 8, WGM = 8;
__host__ __device__ __forceinline__ int lds_byte(int r, int c) { const int st = (r >> 4) * 2 + (c >> 5), rr = r & 15, cc = c & 31, ob = rr * 64 + cc * 2; return st * 1024 + (ob ^ (((ob >> 9) & 1) << 5)); }
__host__ __device__ __forceinline__ void stage_rc(int b, int& R, int& C) { const int st = b / 1024, sb = b % 1024, swz = sb ^ (((sb >> 9) & 1) << 5); R = (st >> 1) * 16 + swz / 64; C = (st & 1) * 32 + (swz % 64) / 2; }
__host__ __device__ __forceinline__ int perm32(int rho) { const int n = rho >> 4, i = rho & 15; return 8 * (i >> 2) + 4 * n + (i & 3); }

struct Unit { int pm, pn, arow, nrows, grp; };
typedef f32x4 Acc[2][2][4][2];

template <class Epi, class Sched, class Ops>
__device__ __forceinline__ void gemm_phase(LAS unsigned char* lds, const Ops& O, const Sched& S, const Epi& E) {
    const int tid = threadIdx.x, wid = __builtin_amdgcn_readfirstlane(tid >> 6), lane = tid & 63, wr = wid >> 2, wc = wid & 3, fr = lane & 15, fq = lane >> 4;
    const int K = O.K, nt = K / BK, ldb = O.ldb;
    int Rr[2], Cc[2]; unsigned voffB[2];
#pragma unroll
    for (int i = 0; i < 2; ++i) { stage_rc(tid * 16 + i * 8192, Rr[i], Cc[i]); const int Rb = Epi::PERM ? ((Rr[i] & ~31) + perm32(Rr[i] & 31)) : Rr[i]; voffB[i] = (unsigned)(Rb * ldb + Cc[i]) * 2u; }
    const size_t kstep = (size_t)(BK * 2);
    const size_t hstepB = (size_t)HALF * ldb * 2;
    const unsigned ldsw = (unsigned)wid * 1024u;
    const int aoff = lds_byte(wr * 64 + fr, fq * 8), boff = lds_byte(wc * 32 + fr, fq * 8);
    const char* const Ab = O.abase;
#define PG_SA(b, h) (((b) * 2 + (h)) * HTB)
#define PG_SB(b, h) ((4 + (b) * 2 + (h)) * HTB)
#define PG_STAGE_B(bufoff, gbase) do { _Pragma("unroll") for (int _i = 0; _i < 2; ++_i) \
        __builtin_amdgcn_global_load_lds((const unsigned*)((const char*)(gbase) + voffB[_i]), (LAS unsigned*)(lds + (bufoff) + ldsw + _i * 8192), 16, 0, 0); } while (0)
#define PG_STAGE_A(bufoff, offs, h, kb) do { _Pragma("unroll") for (int _i = 0; _i < 2; ++_i) \
        __builtin_amdgcn_global_load_lds((const unsigned*)(Ab + (size_t)(offs)[h][_i] + (size_t)(kb)), (LAS unsigned*)(lds + (bufoff) + ldsw + _i * 8192), 16, 0, 0); } while (0)
#define PG_LDA(dst, b, h) do { _Pragma("unroll") for (int m = 0; m < 4; ++m) _Pragma("unroll") for (int k = 0; k < 2; ++k) dst[m][k] = *(const LAS bf16x8*)(lds + PG_SA(b, h) + aoff + m * 2048 + k * 1024); } while (0)
#define PG_LDB(dst, b, h) do { _Pragma("unroll") for (int n = 0; n < 2; ++n) _Pragma("unroll") for (int k = 0; k < 2; ++k) dst[n][k] = *(const LAS bf16x8*)(lds + PG_SB(b, h) + boff + n * 2048 + k * 1024); } while (0)
#define PG_MMA(ai, bj, At, Bt) do { __builtin_amdgcn_s_setprio(1); _Pragma("unroll") for (int m = 0; m < 4; ++m) _Pragma("unroll") for (int n = 0; n < 2; ++n) _Pragma("unroll") for (int k = 0; k < 2; ++k) \
        acc[ai][bj][m][n] = __builtin_amdgcn_mfma_f32_16x16x32_bf16(Bt[n][k], At[m][k], acc[ai][bj][m][n], 0, 0, 0); __builtin_amdgcn_s_setprio(0); } while (0)
#define PG_WAIT_V(n) asm volatile("s_waitcnt vmcnt(" #n ")" ::: "memory")
#define PG_WAIT_L(n) asm volatile("s_waitcnt lgkmcnt(" #n ")" ::: "memory")
#define PG_BAR __builtin_amdgcn_s_barrier()
#define PG_SCHED __builtin_amdgcn_sched_barrier(0)
    Unit cur, nxt; int ui = 0;
    if (!S.next(0, cur)) return;
    Acc acc;
#pragma unroll
    for (int a = 0; a < 2; ++a)
#pragma unroll
        for (int b = 0; b < 2; ++b)
#pragma unroll
            for (int m = 0; m < 4; ++m)
#pragma unroll
                for (int n = 0; n < 2; ++n) acc[a][b][m][n] = (f32x4){0.f, 0.f, 0.f, 0.f};
    bf16x8 At[4][2], B0[2][2], B1[2][2];
    unsigned cOff[2][2], nOff[2][2];
#pragma unroll
    for (int h = 0; h < 2; ++h)
#pragma unroll
        for (int i = 0; i < 2; ++i) cOff[h][i] = O.row_off(cur, h * HALF + Rr[i]) + (unsigned)Cc[i] * 2u;
    const char* cB = O.bptr(cur);
    PG_STAGE_B(PG_SB(0, 0), cB); PG_STAGE_B(PG_SB(0, 1), cB + hstepB); PG_STAGE_A(PG_SA(0, 0), cOff, 0, 0); PG_STAGE_A(PG_SA(0, 1), cOff, 1, 0);
    if (wr == 1) PG_BAR;
    PG_WAIT_V(2); PG_BAR;
    PG_STAGE_B(PG_SB(1, 0), cB + kstep); PG_STAGE_A(PG_SA(1, 0), cOff, 0, kstep); PG_STAGE_B(PG_SB(1, 1), cB + hstepB + kstep);
    PG_WAIT_V(6); PG_BAR;
    for (;;) {
        const bool has_next = S.next(ui + 1, nxt);
        const char* nB = cB;
#pragma unroll
        for (int h = 0; h < 2; ++h)
#pragma unroll
            for (int i = 0; i < 2; ++i) nOff[h][i] = cOff[h][i];
        if (has_next) {
            nB = O.bptr(nxt);
#pragma unroll
            for (int h = 0; h < 2; ++h)
#pragma unroll
                for (int i = 0; i < 2; ++i) nOff[h][i] = O.row_off(nxt, h * HALF + Rr[i]) + (unsigned)Cc[i] * 2u;
        }
        for (int t = 0; t < nt; t += 2) {
            const bool last = (t == nt - 2);
            const size_t k1 = (size_t)(t + 1) * kstep;
            const size_t k2 = last ? (size_t)0 : (size_t)(t + 2) * kstep, k3 = k2 + kstep;
            const char* b2 = last ? nB : cB + (size_t)(t + 2) * kstep; const char* b3 = b2 + kstep;
            unsigned o2[2][2];
#pragma unroll
            for (int h = 0; h < 2; ++h)
#pragma unroll
                for (int i = 0; i < 2; ++i) o2[h][i] = last ? nOff[h][i] : cOff[h][i];
            PG_LDB(B0, 0, 0); PG_LDB(B1, 0, 1); PG_SCHED; PG_LDA(At, 0, 0); PG_STAGE_A(PG_SA(1, 1), cOff, 1, k1);
            PG_WAIT_V(8); PG_WAIT_L(0); PG_BAR; PG_MMA(0, 0, At, B0); PG_MMA(0, 1, At, B1); PG_BAR; PG_SCHED;
            PG_LDA(At, 0, 1); PG_STAGE_B(PG_SB(0, 0), b2); PG_STAGE_B(PG_SB(0, 1), b2 + hstepB); PG_STAGE_A(PG_SA(0, 0), o2, 0, k2);
            PG_WAIT_V(8); PG_WAIT_L(0); PG_BAR; PG_MMA(1, 0, At, B0); PG_MMA(1, 1, At, B1); PG_BAR; PG_SCHED;
            PG_LDB(B0, 1, 0); PG_LDB(B1, 1, 1); PG_SCHED; PG_LDA(At, 1, 0); PG_STAGE_A(PG_SA(0, 1), o2, 1, k2);
            PG_WAIT_V(8); PG_WAIT_L(0); PG_BAR; PG_MMA(0, 0, At, B0); PG_MMA(0, 1, At, B1); PG_BAR; PG_SCHED;
            PG_LDA(At, 1, 1); PG_STAGE_B(PG_SB(1, 0), b3); PG_STAGE_B(PG_SB(1, 1), b3 + hstepB); PG_STAGE_A(PG_SA(1, 0), o2, 0, k3);
            PG_WAIT_V(8); PG_WAIT_L(0); PG_BAR; PG_MMA(1, 0, At, B0); PG_MMA(1, 1, At, B1); PG_BAR; PG_SCHED;
        }
        if (wr == 0) PG_BAR;
        E(acc, cur, wr, wc, fr, fq);
        if (!has_next) break;
#pragma unroll
        for (int a = 0; a < 2; ++a)
#pragma unroll
            for (int b = 0; b < 2; ++b)
#pragma unroll
                for (int m = 0; m < 4; ++m)
#pragma unroll
                    for (int n = 0; n < 2; ++n) acc[a][b][m][n] = (f32x4){0.f, 0.f, 0.f, 0.f};
        cur = nxt; cB = nB; ++ui;
#pragma unroll
        for (int h = 0; h < 2; ++h)
#pragma unroll
            for (int i = 0; i < 2; ++i) cOff[h][i] = nOff[h][i];
        if (wr == 1) PG_BAR;
    }
    PG_WAIT_V(0);
    PG_BAR;
#undef PG_SA
#undef PG_SB
#undef PG_STAGE_A
#undef PG_STAGE_B
#undef PG_LDA
#undef PG_LDB
#undef PG_MMA
#undef PG_WAIT_V
#undef PG_WAIT_L
#undef PG_BAR
#undef PG_SCHED
}
}

using pg::Unit; using pg::Acc;
struct DenseSched {
    int nM, nN, nwg, G, c;
    __device__ void init(int M, int N, int G_, int c_) { nM = (M + 255) / 256; nN = N / 256; nwg = nM * nN; G = G_; c = c_; }
    __device__ bool next(int i, Unit& u) const {
        const long L = (long)i * G + c; if (L >= nwg) return false;
        int wgid = (int)L; { const int q = nwg / pg::NXCD, r = nwg % pg::NXCD, xcd = wgid % pg::NXCD, off = wgid / pg::NXCD; wgid = (xcd < r ? xcd * (q + 1) : r * (q + 1) + (xcd - r) * q) + off; }
        const int nig = pg::WGM * nN, gid = wgid / nig, fm = gid * pg::WGM, gsz = (nM - fm) < pg::WGM ? (nM - fm) : pg::WGM;
        u.pm = fm + ((wgid % nig) % gsz); u.pn = (wgid % nig) / gsz; u.arow = u.pm * 256; u.nrows = 256; u.grp = 0; return true;
    }
};
struct DenseOps {
    const char* abase; const char* bbase; int K, lda, ldb;
    __device__ __forceinline__ unsigned row_off(const Unit& u, int r) const { return (unsigned)(u.arow + r) * (unsigned)lda * 2u; }
    __device__ __forceinline__ const char* bptr(const Unit& u) const { return bbase + (size_t)u.pn * 256 * ldb * 2; }
};
struct S5Sched {
    int G, c;
    __device__ bool next(int i, Unit& u) const {
        const int L = i * G + c; if (L >= S5G * 5) return false;
        u.grp = L / 5; u.pm = L % 5; u.pn = 0; u.arow = u.grp * S5PAD + u.pm * 256; u.nrows = u.pm < 4 ? 256 : 128; return true;
    }
};
struct S5Ops {
    const char* abase; const char* bbase; int K, lda, ldb;
    __device__ __forceinline__ unsigned row_off(const Unit& u, int r) const { return (unsigned)(u.arow + r) * (unsigned)lda * 2u; }
    __device__ __forceinline__ const char* bptr(const Unit& u) const { return bbase + (size_t)u.grp * 256 * ldb * 2; }
};
struct MoeSched {
    const LAS int* tstart; const LAS int* ecnt; const LAS int* estart; int nN, G, c;
    __device__ bool next(int i, Unit& u) const {
        const int L = i * G + c; const int total = tstart[NE];
        if (L >= total * nN) return false;
        const int mtg = L / nN; u.pn = L % nN;
        int e = 0;
#pragma unroll 1
        for (int s = 16; s >= 1; s >>= 1) if (tstart[e + s] <= mtg) e += s;
        u.grp = e; u.pm = mtg - tstart[e]; u.arow = estart[e] + 256 * u.pm; const int left = ecnt[e] - 256 * u.pm; u.nrows = left < 256 ? left : 256; return true;
    }
};
struct MoeUpOps {
    const char* abase; const char* bbase; const int* idx; int K, lda, ldb;
    __device__ __forceinline__ unsigned row_off(const Unit& u, int r) const { const int rr = r < u.nrows ? r : u.nrows - 1; return (unsigned)idx[u.arow + rr] * (unsigned)lda * 2u; }
    __device__ __forceinline__ const char* bptr(const Unit& u) const { return bbase + ((size_t)u.grp * 2048 + (size_t)u.pn * 256) * ldb * 2; }
};
struct MoeDownOps {
    const char* abase; const char* bbase; int K, lda, ldb;
    __device__ __forceinline__ unsigned row_off(const Unit& u, int r) const { return (unsigned)(u.arow + r) * (unsigned)lda * 2u; }
    __device__ __forceinline__ const char* bptr(const Unit& u) const { return bbase + ((size_t)u.grp * 1024 + (size_t)u.pn * 256) * ldb * 2; }
};

struct EpiBf16Gelu {
    static constexpr bool PERM = true;
    bf16* O; int ldc;
    __device__ __forceinline__ void operator()(const Acc& acc, const Unit& u, int wr, int wc, int fr, int fq) const {
        const int row0 = u.arow + wr * 64 + fr, col0 = u.pn * 256 + wc * 32 + 8 * fq;
#pragma unroll
        for (int ai = 0; ai < 2; ++ai)
#pragma unroll
            for (int m = 0; m < 4; ++m) { bf16* rowp = O + (size_t)(row0 + ai * 128 + m * 16) * ldc + col0;
#pragma unroll
                for (int bj = 0; bj < 2; ++bj) { const f32x4 v0 = gelu4(acc[ai][bj][m][0]), v1 = gelu4(acc[ai][bj][m][1]);
                    u32x4 w; w.x = cvt_pk_bf16(v0[0], v0[1]); w.y = cvt_pk_bf16(v0[2], v0[3]); w.z = cvt_pk_bf16(v1[0], v1[1]); w.w = cvt_pk_bf16(v1[2], v1[3]);
                    *(u32x4*)(rowp + bj * 128) = w; } }
    }
};
struct EpiVT {
    static constexpr bool PERM = true;
    bf16* VT; int ldc; float* vssq; int ntok;
    __device__ __forceinline__ void operator()(const Acc& acc, const Unit& u, int wr, int wc, int fr, int fq) const {
        const int row0 = u.arow + wr * 64 + fr, col0 = u.pn * 256 + wc * 32 + 8 * fq;
#pragma unroll
        for (int bj = 0; bj < 2; ++bj) {
            float ss[2][4];
#pragma unroll
            for (int n = 0; n < 2; ++n)
#pragma unroll
                for (int j = 0; j < 4; ++j) ss[n][j] = 0.f;
#pragma unroll
            for (int ai = 0; ai < 2; ++ai)
#pragma unroll
                for (int m = 0; m < 4; ++m) { bf16* rowp = VT + (size_t)(row0 + ai * 128 + m * 16) * ldc + col0 + bj * 128;
                    const f32x4 v0 = gelu4(acc[ai][bj][m][0]), v1 = gelu4(acc[ai][bj][m][1]);
#pragma unroll
                    for (int j = 0; j < 4; ++j) { ss[0][j] += v0[j] * v0[j]; ss[1][j] += v1[j] * v1[j]; }
                    u32x4 w; w.x = cvt_pk_bf16(v0[0], v0[1]); w.y = cvt_pk_bf16(v0[2], v0[3]); w.z = cvt_pk_bf16(v1[0], v1[1]); w.w = cvt_pk_bf16(v1[2], v1[3]);
                    *(u32x4*)rowp = w; }
#pragma unroll
            for (int n = 0; n < 2; ++n)
#pragma unroll
                for (int j = 0; j < 4; ++j) { float t = ss[n][j]; t += __shfl_xor(t, 1); t += __shfl_xor(t, 2); t += __shfl_xor(t, 4); t += __shfl_xor(t, 8); ss[n][j] = t; }
            if (fr == 0) { float* p = vssq + (size_t)(u.pm * 2 + wr) * ntok + col0 + bj * 128;
                *(f32x4*)p = (f32x4){ss[0][0], ss[0][1], ss[0][2], ss[0][3]}; *(f32x4*)(p + 4) = (f32x4){ss[1][0], ss[1][1], ss[1][2], ss[1][3]}; }
            asm volatile("" ::: "memory");
        }
    }
};
struct EpiResid {
    static constexpr bool PERM = false;
    float* H; const float* mod; int goff;
    __device__ __forceinline__ void operator()(const Acc& acc, const Unit& u, int wr, int wc, int fr, int fq) const {
        const int row0 = u.arow + wr * 64 + fr, col0 = u.pn * 256 + wc * 32 + 4 * fq;
        const int b = u.arow < TL ? (u.arow >> 11) : 8;
        const float* gp = mod + (size_t)b * 6144 + goff + col0;
        f32x4 gv[2][2];
#pragma unroll
        for (int bj = 0; bj < 2; ++bj)
#pragma unroll
            for (int n = 0; n < 2; ++n) gv[bj][n] = *(const f32x4*)(gp + bj * 128 + n * 16);
#pragma unroll
        for (int ai = 0; ai < 2; ++ai)
#pragma unroll
            for (int m = 0; m < 4; ++m) { float* rowp = H + (size_t)(row0 + ai * 128 + m * 16) * D + col0;
                f32x4 hv[2][2];
#pragma unroll
                for (int bj = 0; bj < 2; ++bj)
#pragma unroll
                    for (int n = 0; n < 2; ++n) hv[bj][n] = *(const f32x4*)(rowp + bj * 128 + n * 16);
#pragma unroll
                for (int bj = 0; bj < 2; ++bj)
#pragma unroll
                    for (int n = 0; n < 2; ++n) *(f32x4*)(rowp + bj * 128 + n * 16) = hv[bj][n] + gv[bj][n] * acc[ai][bj][m][n];
                if (m & 1) asm volatile("" ::: "memory"); }
    }
};
struct EpiMoeUp {
    static constexpr bool PERM = false;
    bf16* ACT; const float* bgate; const float* bup;
    __device__ __forceinline__ void operator()(const Acc& acc, const Unit& u, int wr, int wc, int fr, int fq) const {
        const int col0 = u.pn * 128 + wc * 32 + 8 * fq;
        const float* bg = bgate + (size_t)u.grp * 1024 + col0; const float* bu = bup + (size_t)u.grp * 1024 + col0;
        f32x4 bgv[2], buv[2];
#pragma unroll
        for (int bj = 0; bj < 2; ++bj) { bgv[bj] = *(const f32x4*)(bg + 4 * bj); buv[bj] = *(const f32x4*)(bu + 4 * bj); }
#pragma unroll
        for (int ai = 0; ai < 2; ++ai)
#pragma unroll
            for (int m = 0; m < 4; ++m) { const int r = ai * 128 + wr * 64 + m * 16 + fr;
                float a[8];
#pragma unroll
                for (int bj = 0; bj < 2; ++bj)
#pragma unroll
                    for (int j = 0; j < 4; ++j) { const float g = fminf(acc[ai][bj][m][0][j] + bgv[bj][j], 7.0f); const float uu = fminf(fmaxf(acc[ai][bj][m][1][j] + buv[bj][j], -7.0f), 7.0f);
                        a[bj * 4 + j] = g * sigmoidf_(1.702f * g) * (uu + 1.0f); }
                u32x4 w; w.x = cvt_pk_bf16(a[0], a[1]); w.y = cvt_pk_bf16(a[2], a[3]); w.z = cvt_pk_bf16(a[4], a[5]); w.w = cvt_pk_bf16(a[6], a[7]);
                if (r < u.nrows) *(u32x4*)(ACT + (size_t)(u.arow + r) * 1024 + col0) = w; }
    }
};
struct EpiMoeDown {
    static constexpr bool PERM = true;
    bf16* Y; const float* bdown; const float* sgate;
    __device__ __forceinline__ void operator()(const Acc& acc, const Unit& u, int wr, int wc, int fr, int fq) const {
        const int col0 = u.pn * 256 + wc * 32 + 8 * fq;
        const float* bp = bdown + (size_t)u.grp * 1024 + col0;
        f32x4 bv[2][2];
#pragma unroll
        for (int bj = 0; bj < 2; ++bj)
#pragma unroll
            for (int n = 0; n < 2; ++n) bv[bj][n] = *(const f32x4*)(bp + bj * 128 + 4 * n);
#pragma unroll
        for (int ai = 0; ai < 2; ++ai)
#pragma unroll
            for (int m = 0; m < 4; ++m) { const int r = ai * 128 + wr * 64 + m * 16 + fr; const bool ok = r < u.nrows;
                const float gt = ok ? sgate[u.arow + r] : 0.f; bf16* rowp = Y + (size_t)(u.arow + r) * 1024 + col0;
#pragma unroll
                for (int bj = 0; bj < 2; ++bj) { const f32x4 v0 = (acc[ai][bj][m][0] + bv[bj][0]) * gt, v1 = (acc[ai][bj][m][1] + bv[bj][1]) * gt;
                    u32x4 w; w.x = cvt_pk_bf16(v0[0], v0[1]); w.y = cvt_pk_bf16(v0[2], v0[3]); w.z = cvt_pk_bf16(v1[0], v1[1]); w.w = cvt_pk_bf16(v1[2], v1[3]);
                    if (ok) *(u32x4*)(rowp + bj * 128) = w; } }
    }
};
struct EpiS5In {
    static constexpr bool PERM = true;
    bf16* XH;
    __device__ __forceinline__ void operator()(const Acc& acc, const Unit& u, int wr, int wc, int fr, int fq) const {
        const int row0 = u.arow + wr * 64 + fr, col0 = u.pn * 256 + wc * 32 + 8 * fq;
#pragma unroll
        for (int ai = 0; ai < 2; ++ai)
#pragma unroll
            for (int m = 0; m < 4; ++m) { const int row = row0 + ai * 128 + m * 16;
#pragma unroll
                for (int bj = 0; bj < 2; ++bj) { const int c = col0 + bj * 128, g = c >> 4, cc = c & 15; const f32x4 v0 = acc[ai][bj][m][0], v1 = acc[ai][bj][m][1];
                    u32x4 w; w.x = cvt_pk_bf16(v0[0], v0[1]); w.y = cvt_pk_bf16(v0[2], v0[3]); w.z = cvt_pk_bf16(v1[0], v1[1]); w.w = cvt_pk_bf16(v1[2], v1[3]);
                    *(u32x4*)(XH + ((size_t)g * S5PAD + (row >> 4)) * 512 + (row & 15) * 16 + cc) = w; } }
    }
};
struct EpiS5State {
    static constexpr bool PERM = false;
    float* S;
    __device__ __forceinline__ void operator()(const Acc& acc, const Unit& u, int wr, int wc, int fr, int fq) const {
        const int col0 = wc * 32 + 4 * fq;
#pragma unroll
        for (int ai = 0; ai < 2; ++ai)
#pragma unroll
            for (int m = 0; m < 4; ++m) { const int r = ai * 128 + wr * 64 + m * 16 + fr; float* rowp = S + (size_t)(u.arow + r) * 256 + col0;
                if (r < u.nrows) {
#pragma unroll
                    for (int bj = 0; bj < 2; ++bj)
#pragma unroll
                        for (int n = 0; n < 2; ++n) *(f32x4*)(rowp + bj * 128 + n * 16) = acc[ai][bj][m][n]; } }
    }
};
struct EpiS5Out {
    static constexpr bool PERM = true;
    bf16* Y;
    __device__ __forceinline__ void operator()(const Acc& acc, const Unit& u, int wr, int wc, int fr, int fq) const {
        const int n0 = wc * 32 + 8 * fq;
#pragma unroll
        for (int ai = 0; ai < 2; ++ai)
#pragma unroll
            for (int m = 0; m < 4; ++m) { const int r = ai * 128 + wr * 64 + m * 16 + fr; const int crow = u.pm * 256 + r;
                if (r < u.nrows) {
#pragma unroll
                    for (int bj = 0; bj < 2; ++bj) { const int n = n0 + bj * 128, t = n >> 4, c = n & 15; const f32x4 v0 = gelu4(acc[ai][bj][m][0]), v1 = gelu4(acc[ai][bj][m][1]);
                        u32x4 w; w.x = cvt_pk_bf16(v0[0], v0[1]); w.y = cvt_pk_bf16(v0[2], v0[3]); w.z = cvt_pk_bf16(v1[0], v1[1]); w.w = cvt_pk_bf16(v1[2], v1[3]);
                        *(u32x4*)(Y + (size_t)(crow * 16 + t) * D + u.grp * 16 + c) = w; } } }
    }
};
struct EpiGlu {
    static constexpr bool PERM = false;
    float* H; const float* mod; int goff;
    __device__ __forceinline__ void operator()(const Acc& acc, const Unit& u, int wr, int wc, int fr, int fq) const {
        const int row0 = u.arow + wr * 64 + fr, col0 = u.pn * 128 + wc * 32 + 8 * fq;
        const int b = u.arow < TL ? (u.arow >> 11) : 8;
        const float* gp = mod + (size_t)b * 6144 + goff + col0;
        f32x4 gv[2];
#pragma unroll
        for (int bj = 0; bj < 2; ++bj) gv[bj] = *(const f32x4*)(gp + 4 * bj);
#pragma unroll
        for (int ai = 0; ai < 2; ++ai)
#pragma unroll
            for (int m = 0; m < 4; ++m) { float* rowp = H + (size_t)(row0 + ai * 128 + m * 16) * D + col0;
                f32x4 hv[2];
#pragma unroll
                for (int bj = 0; bj < 2; ++bj) hv[bj] = *(const f32x4*)(rowp + 4 * bj);
#pragma unroll
                for (int bj = 0; bj < 2; ++bj) { f32x4 o;
#pragma unroll
                    for (int j = 0; j < 4; ++j) o[j] = hv[bj][j] + gv[bj][j] * acc[ai][bj][m][0][j] * sigmoidf_(acc[ai][bj][m][1][j]);
                    *(f32x4*)(rowp + 4 * bj) = o; }
                if (m & 1) asm volatile("" ::: "memory"); }
    }
};
struct EpiMlaIn {
    static constexpr bool PERM = true;
    bf16* Z; float* ssq;
    __device__ __forceinline__ void operator()(const Acc& acc, const Unit& u, int wr, int wc, int fr, int fq) const {
        const int row0 = u.arow + wr * 64 + fr, col0 = u.pn * 256 + wc * 32 + 8 * fq;
#pragma unroll
        for (int ai = 0; ai < 2; ++ai)
#pragma unroll
            for (int m = 0; m < 4; ++m) { const int row = row0 + ai * 128 + m * 16; bf16* rowp = Z + (size_t)row * 768 + col0;
#pragma unroll
                for (int bj = 0; bj < 2; ++bj) { const f32x4 v0 = acc[ai][bj][m][0], v1 = acc[ai][bj][m][1];
                    float s = (v0[0] * v0[0] + v0[1] * v0[1]) + (v0[2] * v0[2] + v0[3] * v0[3]) + (v1[0] * v1[0] + v1[1] * v1[1]) + (v1[2] * v1[2] + v1[3] * v1[3]);
                    s += __shfl_xor(s, 16); s += __shfl_xor(s, 32);
                    u32x4 w; w.x = cvt_pk_bf16(v0[0], v0[1]); w.y = cvt_pk_bf16(v0[2], v0[3]); w.z = cvt_pk_bf16(v1[0], v1[1]); w.w = cvt_pk_bf16(v1[2], v1[3]);
                    *(u32x4*)(rowp + bj * 128) = w;
                    if (fq == 0) ssq[(size_t)row * 24 + u.pn * 8 + bj * 4 + wc] = s; } }
    }
};
template <int MODE> struct EpiMlaUp {
    static constexpr bool PERM = true;
    bf16* O0; bf16* O1; const float* ssq; int s0, ns; float inv_n;
    __device__ __forceinline__ void operator()(const Acc& acc, const Unit& u, int wr, int wc, int fr, int fq) const {
        const int row0 = u.arow + wr * 64 + fr, cl = wc * 32 + 8 * fq;
        const int b = u.arow < TL ? (u.arow >> 11) : ((u.arow - TL) >> 8), key0 = u.arow < TL ? (CTXL + (u.arow & 2047)) : 0;
#pragma unroll
        for (int ai = 0; ai < 2; ++ai)
#pragma unroll
            for (int m = 0; m < 4; ++m) { const int row = row0 + ai * 128 + m * 16; const int rt = wr * 64 + fr + ai * 128 + m * 16;
                const float* sp = ssq + (size_t)row * 24 + s0; float s = 0.f;
                for (int q = 0; q < ns; q += 4) { const f32x4 t = *(const f32x4*)(sp + q); s += (t[0] + t[1]) + (t[2] + t[3]); }
                const float rs = 1.0f / sqrtf(s * inv_n + EPS);
#pragma unroll
                for (int bj = 0; bj < 2; ++bj) { const f32x4 v0 = acc[ai][bj][m][0] * rs, v1 = acc[ai][bj][m][1] * rs;
                    u32x4 w; w.x = cvt_pk_bf16(v0[0], v0[1]); w.y = cvt_pk_bf16(v0[2], v0[3]); w.z = cvt_pk_bf16(v1[0], v1[1]); w.w = cvt_pk_bf16(v1[2], v1[3]);
                    if (MODE == 0) *(u32x4*)(O0 + (size_t)row * 1536 + u.pn * 256 + bj * 128 + cl) = w;
                    else { const size_t kr = ((size_t)(b * NH + u.pn) * KEYS + key0 + rt);
                        if (bj == 0) *(u32x4*)(O0 + kr * DQK + cl) = w; else *(u32x4*)(O1 + kr * DV + cl) = w; } } }
    }
};

constexpr size_t WS_WRT = 60 * MiB;
struct Frame {
    LAS unsigned char* lds; LAS unsigned char* misc;
    unsigned* ctl; unsigned char* ws;
    int tid, lane, wave, vcu, G;
    const float* const* in;
};
template <class Map>
__device__ __forceinline__ void transpose_half(const float* src, int ld, int ncv, int K, int k0, const float* scale, bf16* dst, const Map& map, LAS float* scr, int lane) {
    const int c = lane & 31;
#pragma unroll 8
    for (int i = 0; i < 32; ++i) { const int kk = 2 * i + (lane >> 5); float v = (c < ncv) ? src[(size_t)(k0 + kk) * ld + c] : 0.f; if (scale) v *= scale[k0 + kk]; scr[kk * 33 + c] = v; }
    LDS_WAIT(); asm volatile("" ::: "memory");
    const int c8 = lane & 7;
#pragma unroll
    for (int j = 0; j < 4; ++j) { const int n = (lane >> 3) + 8 * j; const LAS float* s = scr + (8 * c8) * 33 + n;
        u32x4 o; o.x = pk2(s[0 * 33], s[1 * 33]); o.y = pk2(s[2 * 33], s[3 * 33]); o.z = pk2(s[4 * 33], s[5 * 33]); o.w = pk2(s[6 * 33], s[7 * 33]);
        *(u32x4*)(dst + (size_t)map(n) * K + k0 + 8 * c8) = o; }
    LDS_WAIT(); asm volatile("" ::: "memory");
}
struct MapPlain { int n0; __device__ __forceinline__ int operator()(int j) const { return n0 + j; } };
struct MapPair { int cb, ty; __device__ __forceinline__ int operator()(int o) const { return 256 * (cb >> 2) + 128 * ((o >> 2) & 1) + 32 * (cb & 3) + 16 * ty + 4 * (o >> 3) + (o & 3); } };
__device__ __forceinline__ void tr_plain(const float* W, int K, int N, int Npad, const float* scale, bf16* WT, int it, LAS float* scr, int lane) {
    const int nblk = Npad / 32, kb = it / nblk, nb = it % nblk; const int ncv = N - nb * 32;
    transpose_half(W + nb * 32, N, ncv, K, kb * 64, scale, WT, MapPlain{nb * 32}, scr, lane);
}
__device__ __forceinline__ void tr_pair(const float* A, const float* B, int K, int N, int ld, bf16* WT, int it, LAS float* scr, int lane) {
    const int nblk = N / 32, ty = it & 1, r = it >> 1, kb = r / nblk, cb = r % nblk;
    transpose_half((ty ? B : A) + cb * 32, ld, 32, K, kb * 64, nullptr, WT, MapPair{cb, ty}, scr, lane);
}

__device__ __forceinline__ void p0_prologue(Frame& F) {
    const float* const* in = F.in;
    unsigned char* ws = F.ws;
    LAS float* silu = (LAS float*)(F.lds + 90112);
    for (int i = F.tid; i < 9 * 1024; i += NTHREADS) { const float c = i < 8192 ? in[1][i] : in[3][i - 8192]; silu[i] = c * sigmoidf_(c); }
    __syncthreads();
    {
        LAS float* red = (LAS float*)F.lds;
        float* MOD = (float*)(ws + WS_MOD);
        for (int it = F.vcu; it < DEPTH * 96; it += F.G) {
            const int l = it / 96, cb = it % 96, col = cb * 64 + F.lane;
            const float* w = in[4] + (size_t)l * 1024 * 6144 + col;
            float acc[9];
#pragma unroll
            for (int r = 0; r < 9; ++r) acc[r] = 0.f;
            const int kbase = F.wave * 128;
#pragma unroll 8
            for (int k = 0; k < 128; ++k) { const float wv = w[(size_t)(kbase + k) * 6144];
#pragma unroll
                for (int r = 0; r < 9; ++r) acc[r] += silu[r * 1024 + kbase + k] * wv; }
#pragma unroll
            for (int r = 0; r < 9; ++r) red[(F.wave * 9 + r) * 64 + F.lane] = acc[r];
            __syncthreads();
            for (int o = F.tid; o < 9 * 64; o += NTHREADS) { const int r = o / 64, c = o % 64; float s = 0.f;
#pragma unroll
                for (int wv = 0; wv < 8; ++wv) s += red[(wv * 9 + r) * 64 + c];
                MOD[((size_t)l * 9 + r) * 6144 + cb * 64 + c] = s + in[5][(size_t)l * 6144 + cb * 64 + c]; }
            __syncthreads();
        }
    }
    if (F.vcu >= F.G - S5G) {
        const int g = F.vcu - (F.G - S5G);
        LAS float* apr = (LAS float*)F.lds;
        LAS float* api = apr + 2 * 64 * 17;
        LAS float* bbr = api + 2 * 64 * 17;
        LAS float* bbi = bbr + 2 * 64 * 16;
        LAS float* ccr = bbi + 2 * 64 * 16;
        LAS float* cci = ccr + 2 * 16 * 64;
        LAS float* klg = cci + 2 * 16 * 64;
        static_assert((2 * 64 * 17 * 2 + 2 * 64 * 16 * 2 + 2 * 16 * 64 * 2 + 2 * 16 * 256) * 4 <= 90112, "S5 scratch");
        const float* lam_re = in[14]; const float* lam_im = in[15]; const float* log_dt = in[16];
        const float* b_re = in[17]; const float* b_im = in[18]; const float* c_re = in[19]; const float* c_im = in[20]; const float* dsk = in[21];
        if (F.tid < 128) {
            const int dir = F.tid >> 6, p = F.tid & 63; const int gp = (dir * S5G + g) * 64 + p;
            const float dt = expf(log_dt[dir * S5G + g]), lr = lam_re[gp], li = lam_im[gp];
            const float mag = expf(lr * dt); float sn, cs; sincosf(li * dt, &sn, &cs); const float ar = mag * cs, ai = mag * sn;
            { float pr = 1.0f, pi = 0.0f;
              for (int l = 0; l <= 16; ++l) { apr[(dir * 64 + p) * 17 + l] = pr; api[(dir * 64 + p) * 17 + l] = pi; const float t = pr * ar - pi * ai; pi = pr * ai + pi * ar; pr = t; } }
            const float den = lr * lr + li * li, nr = ar - 1.0f; const float fr_ = (nr * lr + ai * li) / den, fi_ = (ai * lr - nr * li) / den;
            for (int c = 0; c < 16; ++c) { const float br = b_re[(size_t)gp * 16 + c], bi = b_im[(size_t)gp * 16 + c]; bbr[(dir * 64 + p) * 16 + c] = fr_ * br - fi_ * bi; bbi[(dir * 64 + p) * 16 + c] = fr_ * bi + fi_ * br; }
            float* A16 = (float*)(ws + WS_A16) + ((size_t)(g * 2 + dir) * 2) * 64;
            A16[p] = apr[(dir * 64 + p) * 17 + 16]; A16[64 + p] = api[(dir * 64 + p) * 17 + 16];
        }
        for (int i = F.tid; i < 2 * 16 * 64; i += NTHREADS) { const int dir = i / 1024, r = i % 1024; ccr[i] = c_re[((size_t)(dir * S5G + g)) * 1024 + r]; cci[i] = c_im[((size_t)(dir * S5G + g)) * 1024 + r]; }
        __syncthreads();
        {
            const int dir = F.tid >> 8, l = (F.tid >> 4) & 15, c = F.tid & 15;
            float acc[16];
#pragma unroll
            for (int q = 0; q < 16; ++q) acc[q] = 0.f;
            for (int p = 0; p < 64; ++p) { const float cr = ccr[(dir * 16 + c) * 64 + p], ci = cci[(dir * 16 + c) * 64 + p], ar = apr[(dir * 64 + p) * 17 + l], ai = api[(dir * 64 + p) * 17 + l];
                const float zr = cr * ar - ci * ai, zi = cr * ai + ci * ar;
#pragma unroll
                for (int q = 0; q < 16; ++q) acc[q] += zr * bbr[(dir * 64 + p) * 16 + q] - zi * bbi[(dir * 64 + p) * 16 + q]; }
#pragma unroll
            for (int q = 0; q < 16; ++q) klg[((dir * 16 + l) * 16 + c) * 16 + q] = acc[q];
        }
        __syncthreads();
        bf16* TET = (bf16*)(ws + WS_TET) + (size_t)g * 256 * 512; bf16* GT = (bf16*)(ws + WS_GT) + (size_t)g * 256 * 256;
        for (int q = F.tid; q < 256 * 64; q += NTHREADS) { const int n = q >> 6, kc = q & 63, t = n >> 4, c = n & 15; float v[8];
            if (kc < 32) { const int s = kc >> 1, c0 = (kc & 1) * 8;
#pragma unroll
                for (int j = 0; j < 8; ++j) { float x = 0.f; if (s <= t) x += klg[((0 * 16 + (t - s)) * 16 + c) * 16 + c0 + j]; if (s >= t) x += klg[((1 * 16 + (s - t)) * 16 + c) * 16 + c0 + j];
                    if (s == t && c == c0 + j) x += dsk[g * 16 + c]; v[j] = x; }
            } else { const int kk = (kc - 32) * 8, dir = kk >> 7, ri = (kk >> 6) & 1, p0 = kk & 63; const int pw = dir == 0 ? (t + 1) : (16 - t);
#pragma unroll
                for (int j = 0; j < 8; ++j) { const int p = p0 + j; const float cr = ccr[(dir * 16 + c) * 64 + p], ci = cci[(dir * 16 + c) * 64 + p], ar = apr[(dir * 64 + p) * 17 + pw], ai = api[(dir * 64 + p) * 17 + pw];
                    v[j] = ri == 0 ? (cr * ar - ci * ai) : -(cr * ai + ci * ar); } }
            u32x4 o; o.x = pk2(v[0], v[1]); o.y = pk2(v[2], v[3]); o.z = pk2(v[4], v[5]); o.w = pk2(v[6], v[7]);
            *(u32x4*)(TET + (size_t)n * 512 + kc * 8) = o; }
        for (int q = F.tid; q < 256 * 32; q += NTHREADS) { const int n = q >> 5, kc = q & 31, dir = n >> 7, ri = (n >> 6) & 1, p = n & 63, s = kc >> 1, c0 = (kc & 1) * 8; const int pw = dir == 0 ? (15 - s) : s;
            const float ar = apr[(dir * 64 + p) * 17 + pw], ai = api[(dir * 64 + p) * 17 + pw]; float v[8];
#pragma unroll
            for (int j = 0; j < 8; ++j) { const float br = bbr[(dir * 64 + p) * 16 + c0 + j], bi = bbi[(dir * 64 + p) * 16 + c0 + j]; v[j] = ri == 0 ? (ar * br - ai * bi) : (ar * bi + ai * br); }
            u32x4 o; o.x = pk2(v[0], v[1]); o.y = pk2(v[2], v[3]); o.z = pk2(v[4], v[5]); o.w = pk2(v[6], v[7]);
            *(u32x4*)(GT + (size_t)n * 256 + kc * 8) = o; }
        __syncthreads();
    }
    {
        const size_t gt = (size_t)F.vcu * NTHREADS + F.tid, GT_ = (size_t)F.G * NTHREADS;
        f32x4* H4 = (f32x4*)(ws + WS_H); const f32x4* x4 = (const f32x4*)in[0]; const f32x4* c4 = (const f32x4*)in[2];
        for (size_t i = gt; i < (size_t)TT * 256; i += GT_) H4[i] = i < (size_t)TL * 256 ? x4[i] : c4[i - (size_t)TL * 256];
        float* WRT = (float*)(ws + WS_WRT);
        for (size_t i = gt; i < (size_t)DEPTH * 32 * 1024; i += GT_) { const int l = (int)(i >> 15), e = (int)(i >> 10) & 31, k = (int)i & 1023; WRT[i] = in[31][((size_t)l * 1024 + k) * 32 + e]; }
    }
    {
        LAS float* scr = (LAS float*)(F.lds + F.wave * 8448);
        const int gw = F.vcu * NWAVES + F.wave, NGW = F.G * NWAVES;
        constexpr int I_SGIN = 16 * 64, I_SGOUT = 16 * 32, I_SSMIN = 16 * 32, I_GLU = 16 * 32 * 2, I_MLAIN = 16 * 24, I_UQ = 6 * 48, I_UKV = 4 * 64, I_MLAOUT = 16 * 32;
        constexpr int I_SMALL = 2 * I_SGIN + 2 * I_SGOUT + I_SSMIN + I_GLU + I_MLAIN + I_UQ + I_UKV + I_MLAOUT;
        constexpr int I_GU = 16 * 32 * 2, I_DN = 16 * 32, I_EXP = I_GU + I_DN;
        constexpr int NITEMS = I_SMALL + DEPTH * NE * I_EXP;
        for (int it = gw; it < NITEMS; it += NGW) {
            int r = it;
            if (r < 2 * I_SGIN) { const int sl = r / I_SGIN; tr_plain(in[8] + (size_t)sl * 1024 * 2048, 1024, 2048, 2048, nullptr, (bf16*)(ws + WS_WSGIN) + (size_t)sl * 2048 * 1024, r % I_SGIN, scr, F.lane); continue; } r -= 2 * I_SGIN;
            if (r < 2 * I_SGOUT) { const int sl = r / I_SGOUT; tr_plain(in[12] + (size_t)sl * 1024 * 1024, 1024, 1024, 1024, nullptr, (bf16*)(ws + WS_WSGOUT) + (size_t)sl * 1024 * 1024, r % I_SGOUT, scr, F.lane); continue; } r -= 2 * I_SGOUT;
            if (r < I_SSMIN) { tr_plain(in[13], 1024, 1024, 1024, nullptr, (bf16*)(ws + WS_WSSMIN), r, scr, F.lane); continue; } r -= I_SSMIN;
            if (r < I_GLU) { tr_pair(in[22], in[22] + 1024, 1024, 1024, 2048, (bf16*)(ws + WS_WGLU), r, scr, F.lane); continue; } r -= I_GLU;
            if (r < I_MLAIN) { tr_plain(in[23], 1024, 704, 768, nullptr, (bf16*)(ws + WS_WMLAIN), r, scr, F.lane); continue; } r -= I_MLAIN;
            if (r < I_UQ) { tr_plain(in[26], 384, 1536, 1536, in[24], (bf16*)(ws + WS_WUQ), r, scr, F.lane); continue; } r -= I_UQ;
            if (r < I_UKV) { tr_plain(in[27], 256, 2048, 2048, in[25], (bf16*)(ws + WS_WUKV), r, scr, F.lane); continue; } r -= I_UKV;
            if (r < I_MLAOUT) { tr_plain(in[30], 1024, 1024, 1024, nullptr, (bf16*)(ws + WS_WMLAOUT), r, scr, F.lane); continue; } r -= I_MLAOUT;
            const int le = r / I_EXP, q = r % I_EXP;
            if (q < I_GU) tr_pair(in[33] + (size_t)le * 1024 * 1024, in[35] + (size_t)le * 1024 * 1024, 1024, 1024, 1024, (bf16*)(ws + WS_WGU) + (size_t)le * 2048 * 1024, q, scr, F.lane);
            else tr_plain(in[37] + (size_t)le * 1024 * 1024, 1024, 1024, 1024, nullptr, (bf16*)(ws + WS_WD) + (size_t)le * 1024 * 1024, q - I_GU, scr, F.lane);
        }
    }
}

#define HALVE(NH_, M_) do { const bool up_ = (F.lane & (M_)) != 0; _Pragma("unroll") for (int i_ = 0; i_ < (NH_); ++i_) { const float a_ = lg[i_], b_ = lg[i_ + (NH_)]; \
        const float snd_ = up_ ? a_ : b_, kp_ = up_ ? b_ : a_; lg[i_] = kp_ + __shfl_xor(snd_, (M_)); } } while (0)
template <bool COMBINE, bool ROUTER>
__device__ __forceinline__ void norm_phase(Frame& F, int nrows, const float* gain, const float* modl, int shoff, int scoff,
                                           const float* modprev, const bf16* Y, const int* tokslot, float* Hbuf, bf16* NBout,
                                           const float* wrt, const float* brouter, int* tope, float* topg, unsigned* histg) {
    LAS float* wl = (LAS float*)F.lds;
    LAS int* hist = (LAS int*)(F.misc + MI_HIST);
    if (ROUTER) {
        for (int i = F.tid; i < 8192; i += NTHREADS) ((LAS f32x4*)wl)[i] = ((const f32x4*)wrt)[i];
        if (F.tid < 32) hist[F.tid] = 0;
        __syncthreads();
    }
    const int gw = F.vcu * NWAVES + F.wave, NGW = F.G * NWAVES;
    f32x4 gn[4];
#pragma unroll
    for (int j = 0; j < 4; ++j) gn[j] = ((const f32x4*)gain)[F.lane + 64 * j];
    for (int row = gw; row < nrows; row += NGW) {
        const int b = row < TL ? (row >> 11) : 8;
        f32x4* hrow = (f32x4*)(Hbuf + (size_t)row * D);
        f32x4 v[4];
#pragma unroll
        for (int j = 0; j < 4; ++j) v[j] = hrow[F.lane + 64 * j];
        if (COMBINE) {
            const f32x4* g5 = (const f32x4*)(modprev + (size_t)b * 6144 + 5120);
            f32x4 ys[4];
#pragma unroll
            for (int j = 0; j < 4; ++j) ys[j] = (f32x4){0.f, 0.f, 0.f, 0.f};
#pragma unroll
            for (int k = 0; k < 4; ++k) { const int slot = tokslot[row * 4 + k]; const u32x2* yr = (const u32x2*)(Y + (size_t)slot * D);
#pragma unroll
                for (int j = 0; j < 4; ++j) { const u32x2 y = yr[F.lane + 64 * j]; ys[j] += (f32x4){bf2f(y.x & 0xffffu), bf2f(y.x >> 16), bf2f(y.y & 0xffffu), bf2f(y.y >> 16)}; } }
#pragma unroll
            for (int j = 0; j < 4; ++j) { v[j] += g5[F.lane + 64 * j] * ys[j]; hrow[F.lane + 64 * j] = v[j]; }
        }
        float s = 0.f;
#pragma unroll
        for (int j = 0; j < 4; ++j) s += (v[j][0] * v[j][0] + v[j][1] * v[j][1]) + (v[j][2] * v[j][2] + v[j][3] * v[j][3]);
        const float rstd = 1.0f / sqrtf(wave_sum(s) * (1.0f / D) + EPS);
        const f32x4* sh = (const f32x4*)(modl + (size_t)b * 6144 + shoff); const f32x4* sc = (const f32x4*)(modl + (size_t)b * 6144 + scoff);
        u32x2* orow = (u32x2*)(NBout + (size_t)row * D);
#pragma unroll
        for (int j = 0; j < 4; ++j) { v[j] = (v[j] * rstd) * gn[j] * (sc[F.lane + 64 * j] + 1.0f) + sh[F.lane + 64 * j];
            u32x2 o; o.x = pk2(v[j][0], v[j][1]); o.y = pk2(v[j][2], v[j][3]); orow[F.lane + 64 * j] = o; }
        if (ROUTER) {
            float lg[32];
#pragma unroll
            for (int e = 0; e < 32; ++e) lg[e] = 0.f;
#pragma unroll
            for (int j = 0; j < 4; ++j)
#pragma unroll
                for (int e = 0; e < 32; ++e) { const f32x4 w4 = ((const LAS f32x4*)wl)[e * 256 + F.lane + 64 * j]; lg[e] += (v[j][0] * w4[0] + v[j][1] * w4[1]) + (v[j][2] * w4[2] + v[j][3] * w4[3]); }
            HALVE(16, 32); HALVE(8, 16); HALVE(4, 8); HALVE(2, 4); HALVE(1, 2);
            float val = lg[0] + __shfl_xor(lg[0], 1);
            const int me = F.lane >> 1;
            val += brouter[me];
            int se[4]; float sv[4];
#pragma unroll
            for (int k = 0; k < 4; ++k) { const float mx = wave_max(val); const unsigned long long bl = __ballot(val == mx); const int first = __ffsll((long long)bl) - 1; const int e = first >> 1;
                se[k] = e; sv[k] = mx; if (me == e) val = -INFINITY; }
            const float e1 = __expf(sv[1] - sv[0]), e2 = __expf(sv[2] - sv[0]), e3 = __expf(sv[3] - sv[0]); const float inv = 1.0f / (1.0f + e1 + e2 + e3);
            if (F.lane == 0) {
                *(int4*)(tope + (size_t)row * 4) = make_int4(se[0], se[1], se[2], se[3]);
                *(f32x4*)(topg + (size_t)row * 4) = (f32x4){inv, e1 * inv, e2 * inv, e3 * inv};
#pragma unroll
                for (int k = 0; k < 4; ++k) atomicAdd((int*)&hist[se[k]], 1);
            }
        }
    }
    if (ROUTER) { __syncthreads(); if (F.tid < 32) histg[F.tid] = (unsigned)hist[F.tid]; }
}

__device__ __forceinline__ void dispatch_phase(Frame& F, int nrows, const unsigned* histl  , unsigned* moetab  ,
                                               const int* tope, const float* topg, int* tokslot, int* slottok, float* slotgate) {
    LAS int* pall = (LAS int*)(F.misc + MI_SCR);
    LAS int* pbef = pall + 512;
    LAS int* cnt = (LAS int*)(F.misc + MI_HIST);
    LAS int* tot = (LAS int*)(F.misc + MI_ECNT);
    LAS int* start = (LAS int*)(F.misc + MI_ESTART);
    LAS int* wbase = (LAS int*)(F.misc + MI_TSTART);
    {
        const int e = F.tid & 31, part = F.tid >> 5; int sa = 0, sb = 0;
        const int per = (F.G + 15) / 16;
        for (int i = 0; i < per; ++i) { const int c = part * per + i; if (c < F.G) { const int hv = (int)histl[c * 32 + e]; sa += hv; if (c < F.vcu) sb += hv; } }
        pall[part * 32 + e] = sa; pbef[part * 32 + e] = sb;
    }
    __syncthreads();
    if (F.tid < 32) { int sa = 0, sb = 0;
#pragma unroll
        for (int p = 0; p < 16; ++p) { sa += pall[p * 32 + F.tid]; sb += pbef[p * 32 + F.tid]; }
        tot[F.tid] = sa; wbase[F.tid] = sb; cnt[F.tid] = 0; }
    __syncthreads();
    if (F.tid == 0) { int acc = 0; for (int e = 0; e < 32; ++e) { start[e] = acc; acc += tot[e]; } }
    __syncthreads();
    if (F.vcu == 0 && F.tid < 32) { moetab[F.tid] = (unsigned)tot[F.tid]; moetab[32 + F.tid] = (unsigned)start[F.tid]; }
    const int NGW = F.G * NWAVES, rpw = nrows / NGW;
    for (int idx = F.tid; idx < rpw * NWAVES * 4; idx += NTHREADS) {
        const int rr = idx >> 2, k = idx & 3; const int row = F.vcu * NWAVES + (rr & 7) + NGW * (rr >> 3);
        const int e = tope[row * 4 + k]; const int rank = atomicAdd((int*)&cnt[e], 1); const int slot = start[e] + wbase[e] + rank;
        slottok[slot] = row; slotgate[slot] = topg[row * 4 + k]; tokslot[row * 4 + k] = slot;
    }
    __syncthreads();
}
__device__ __forceinline__ void moe_tables(Frame& F, const unsigned* moetab) {
    LAS int* tstart = (LAS int*)(F.misc + MI_TSTART); LAS int* ecnt = (LAS int*)(F.misc + MI_ECNT); LAS int* estart = (LAS int*)(F.misc + MI_ESTART);
    __syncthreads();
    if (F.tid < 32) { ecnt[F.tid] = (int)moetab[F.tid]; estart[F.tid] = (int)moetab[32 + F.tid]; }
    __syncthreads();
    if (F.tid == 0) { int acc = 0; for (int e = 0; e < 32; ++e) { tstart[e] = acc; acc += (ecnt[e] + 255) >> 8; } tstart[32] = acc; }
    __syncthreads();
}

__device__ __forceinline__ void spatial_phase(Frame& F, int nchunks, const float* w_s  , const float* b_s  , const float* g_v  ,
                                              const bf16* VT, const float* vssq, const bf16* U, bf16* Z) {
    LAS float* rs = (LAS float*)(F.misc + MI_SCR);
    const int fr = F.lane & 15, fq = F.lane >> 4;
    for (int ui = F.vcu; ui < nchunks * 8; ui += F.G) {
        const int chunk = ui >> 3, g = ui & 7;
        __syncthreads();
        if (F.tid < 128) { const int tok = chunk * 128 + F.tid; float s = 0.f;
#pragma unroll
            for (int i = 0; i < 8; ++i) s += vssq[(size_t)i * TT + tok];
            rs[F.tid] = 1.0f / sqrtf(s * (1.0f / 1024.0f) + EPS); }
        __syncthreads();
        const int p = 16 * F.wave + fr;
        f32x4 acc[8];
#pragma unroll
        for (int n = 0; n < 8; ++n) acc[n] = (f32x4){0.f, 0.f, 0.f, 0.f};
        const float* wrow = w_s + ((size_t)g * 128 + p) * 128;
#pragma unroll
        for (int kk = 0; kk < 4; ++kk) { const int q0 = 32 * kk + 8 * fq;
            const f32x4 w0 = *(const f32x4*)(wrow + q0), w1 = *(const f32x4*)(wrow + q0 + 4);
            const f32x4 r0 = *(const LAS f32x4*)(rs + q0), r1 = *(const LAS f32x4*)(rs + q0 + 4);
            u32x4 aw; aw.x = pk2(w0[0] * r0[0], w0[1] * r0[1]); aw.y = pk2(w0[2] * r0[2], w0[3] * r0[3]); aw.z = pk2(w1[0] * r1[0], w1[1] * r1[1]); aw.w = pk2(w1[2] * r1[2], w1[3] * r1[3]);
            const bf16x8 af = __builtin_bit_cast(bf16x8, aw);
#pragma unroll
            for (int n = 0; n < 8; ++n) { const bf16x8 bf = *(const bf16x8*)(VT + (size_t)(g * 128 + 16 * n + fr) * TT + chunk * 128 + q0);
                acc[n] = __builtin_amdgcn_mfma_f32_16x16x32_bf16(bf, af, acc[n], 0, 0, 0); } }
        const int tok = chunk * 128 + p; const float bs = b_s[g * 128 + p];
#pragma unroll
        for (int n = 0; n < 8; ++n) { const int c0 = g * 128 + 16 * n + 4 * fq; const f32x4 gv = *(const f32x4*)(g_v + c0);
            const u32x2 uu = *(const u32x2*)(U + (size_t)tok * D + c0);
            const float z0 = bf2f(uu.x & 0xffffu) * (acc[n][0] * gv[0] + bs), z1 = bf2f(uu.x >> 16) * (acc[n][1] * gv[1] + bs), z2 = bf2f(uu.y & 0xffffu) * (acc[n][2] * gv[2] + bs), z3 = bf2f(uu.y >> 16) * (acc[n][3] * gv[3] + bs);
            u32x2 o; o.x = pk2(z0, z1); o.y = pk2(z2, z3); *(u32x2*)(Z + (size_t)tok * D + c0) = o; }
    }
}

__device__ __forceinline__ void s5_scan_phase(Frame& F, const float* SBuf, bf16* XH, const float* A16) {
    for (int it = F.wave * F.G + F.vcu; it < NB * S5G * 2; it += F.G * NWAVES) {
        const int b = it & 7, g = (it >> 3) & 63, dir = it >> 9, p = F.lane;
        const float ar = A16[((size_t)(g * 2 + dir) * 2) * 64 + p], ai = A16[((size_t)(g * 2 + dir) * 2 + 1) * 64 + p];
        float hr = 0.f, hi = 0.f;
        for (int i0 = 0; i0 < 144; i0 += 8) {
            float sr[8], si[8]; int rix[8];
#pragma unroll
            for (int j = 0; j < 8; ++j) { const int i = i0 + j; int r;
                if (dir == 0) r = i < 16 ? (1024 + b * 16 + i) : (b * 128 + (i - 16)); else r = i < 16 ? (1024 + b * 16 + (15 - i)) : (b * 128 + (127 - (i - 16)));
                rix[j] = r; const float* sp = SBuf + ((size_t)g * S5PAD + r) * 256 + dir * 128 + p; sr[j] = sp[0]; si[j] = sp[64]; }
#pragma unroll
            for (int j = 0; j < 8; ++j) { bf16* hp = XH + ((size_t)g * S5PAD + rix[j]) * 512 + 256 + dir * 128 + p;
                hp[0] = (bf16)f2bf(hr); hp[64] = (bf16)f2bf(hi);
                const float nr = ar * hr - ai * hi + sr[j], ni = ar * hi + ai * hr + si[j]; hr = nr; hi = ni; }
        }
    }
}

__device__ __forceinline__ void qk_finalize_phase(Frame& F, const bf16* QR, const bf16* ZL, bf16* QF, bf16* KF, const float* g_qn, const float* g_kn) {
    const int gw = F.vcu * NWAVES + F.wave, NGW = F.G * NWAVES, l = F.lane;
    const float gq0 = g_qn[2 * l], gq1 = g_qn[2 * l + 1], gq2 = g_qn[128 + l], gk0 = g_kn[2 * l], gk1 = g_kn[2 * l + 1], gk2 = g_kn[128 + l];
    const int ax = l >> 5, fi = l & 15, half = (l >> 4) & 1;
    const float invf = __builtin_amdgcn_exp2f(-(float)fi * (13.287712379549449f / 16.0f));
    for (int row = gw; row < TT; row += NGW) {
        const bool lat = row < TL; const int b = lat ? (row >> 11) : ((row - TL) >> 8), s = lat ? (row & 2047) : ((row - TL) & 255), key = lat ? (CTXL + s) : s;
        float cs = 1.0f, sn = 0.0f;
        if (lat) { const float pos = (float)(ax == 0 ? (s >> 6) : (s & 63)); sincosf(pos * invf, &sn, &cs); }
        const float kpe = bf2f(ZL[(size_t)row * 768 + 640 + l]);
        const float kss = wave_sum(kpe * kpe);
#pragma unroll 1
        for (int h = 0; h < NH; ++h) {
            const size_t o = ((size_t)(b * NH + h) * KEYS + key) * DQK;
            {
                const bf16* qp = QR + (size_t)row * 1536 + h * 192; const unsigned qn = *(const unsigned*)(qp + 2 * l); float x0 = bf2f(qn & 0xffffu), x1 = bf2f(qn >> 16), x2 = bf2f(qp[128 + l]);
                const float rstd = 1.0f / sqrtf(wave_sum(x0 * x0 + x1 * x1 + x2 * x2) * (1.0f / 192.0f) + EPS);
                x0 *= rstd * gq0; x1 *= rstd * gq1; x2 *= rstd * gq2;
                const float pr = __shfl_xor(x2, 16); const float xr = half == 0 ? (x2 * cs - pr * sn) : (x2 * cs + pr * sn);
                *(unsigned*)(QF + o + 2 * l) = pk2(x0, x1); QF[o + 128 + l] = (bf16)f2bf(xr);
            }
            {
                const unsigned kn = *(const unsigned*)(KF + o + 2 * l); float x0 = bf2f(kn & 0xffffu), x1 = bf2f(kn >> 16), x2 = kpe;
                const float rstd = 1.0f / sqrtf((wave_sum(x0 * x0 + x1 * x1) + kss) * (1.0f / 192.0f) + EPS);
                x0 *= rstd * gk0; x1 *= rstd * gk1; x2 *= rstd * gk2;
                const float pr = __shfl_xor(x2, 16); const float xr = half == 0 ? (x2 * cs - pr * sn) : (x2 * cs + pr * sn);
                *(unsigned*)(KF + o + 2 * l) = pk2(x0, x1); KF[o + 128 + l] = (bf16)f2bf(xr);
            }
        }
    }
}

__device__ __forceinline__ void final_phase(Frame& F, const float* Hbuf, const float* modprev, const bf16* Y, const int* tokslot, float* out) {
    const int gw = F.vcu * NWAVES + F.wave, NGW = F.G * NWAVES;
    for (int row = gw; row < TL; row += NGW) {
        const int b = row >> 11; const f32x4* hrow = (const f32x4*)(Hbuf + (size_t)row * D); const f32x4* g5 = (const f32x4*)(modprev + (size_t)b * 6144 + 5120);
        f32x4 ys[4];
#pragma unroll
        for (int j = 0; j < 4; ++j) ys[j] = (f32x4){0.f, 0.f, 0.f, 0.f};
#pragma unroll
        for (int k = 0; k < 4; ++k) { const int slot = tokslot[row * 4 + k]; const u32x2* yr = (const u32x2*)(Y + (size_t)slot * D);
#pragma unroll
            for (int j = 0; j < 4; ++j) { const u32x2 y = yr[F.lane + 64 * j]; ys[j] += (f32x4){bf2f(y.x & 0xffffu), bf2f(y.x >> 16), bf2f(y.y & 0xffffu), bf2f(y.y >> 16)}; } }
        f32x4* orow = (f32x4*)(out + (size_t)row * D);
#pragma unroll
        for (int j = 0; j < 4; ++j) orow[F.lane + 64 * j] = hrow[F.lane + 64 * j] + g5[F.lane + 64 * j] * ys[j];
    }
}

namespace att {
constexpr int NWv = 8, QBLK = 32, KVBLK = 64;
constexpr float SCALE = 0.07216878364870322f;
constexpr float THR = 8.f;
constexpr int SHM_V = KVBLK * DV * 2, SHM_K = KVBLK * DQK * 2;
constexpr int LDS_ATT = 2 * SHM_V + 2 * SHM_K + NWv * 64 * 4;
#define KSWZ(row, colB) ((row) * 384 + ((colB) ^ ((((row) >> 1) & 7) << 4)))
#define SBAR() __builtin_amdgcn_sched_barrier(0)
__device__ __forceinline__ int crow(int r, int hi) { return (r & 3) + 8 * (r >> 2) + 4 * hi; }
__device__ __forceinline__ void partialSM(f32x16& p0, f32x16& p1, float& m_reg, float& mn, float& alpha) {
  constexpr float C = SCALE * 1.4426950408889634f;
  float pmax = p0[0];
#pragma unroll
  for (int r = 1; r < 16; ++r) pmax = fmaxf(pmax, p0[r]);
#pragma unroll
  for (int r = 0; r < 16; ++r) pmax = fmaxf(pmax, p1[r]);
  { auto rr = __builtin_amdgcn_permlane32_swap(__float_as_uint(pmax), __float_as_uint(pmax), false, false);
    pmax = fmaxf(__uint_as_float(rr[0]), __uint_as_float(rr[1])); }
  if (__builtin_expect(__all(pmax - m_reg <= THR / SCALE), 1)) { mn = m_reg; alpha = 1.f; }
  else { mn = fmaxf(m_reg, pmax); alpha = __builtin_amdgcn_exp2f((m_reg - mn) * C); m_reg = mn; }
  const float mnC = -mn * C;
#pragma unroll
  for (int r = 0; r < 16; ++r) p0[r] = fmaf(p0[r], C, mnC);
#pragma unroll
  for (int r = 0; r < 16; ++r) p1[r] = fmaf(p1[r], C, mnC);
#pragma unroll
  for (int r = 0; r < 16; ++r) p0[r] = __builtin_amdgcn_exp2f(p0[r]);
}
__device__ __forceinline__ void finishSM(f32x16& p0, f32x16& p1, float alpha, float& l_reg, bf16x8& pa0, bf16x8& pa1, bf16x8& pa2, bf16x8& pa3) {
#pragma unroll
  for (int r = 0; r < 16; ++r) p1[r] = __builtin_amdgcn_exp2f(p1[r]);
  float ps = 0;
#pragma unroll
  for (int r = 0; r < 16; ++r) ps += p0[r];
#pragma unroll
  for (int r = 0; r < 16; ++r) ps += p1[r];
  { auto rr = __builtin_amdgcn_permlane32_swap(__float_as_uint(ps), __float_as_uint(ps), false, false);
    ps = __uint_as_float(rr[0]) + __uint_as_float(rr[1]); }
  l_reg = l_reg * alpha + ps;
#define PK4(P, BASE, OUT) do { unsigned a0 = cvt_pk_bf16(P[BASE + 0], P[BASE + 1]), a1 = cvt_pk_bf16(P[BASE + 2], P[BASE + 3]);   \
    unsigned b0 = cvt_pk_bf16(P[BASE + 4], P[BASE + 5]), b1 = cvt_pk_bf16(P[BASE + 6], P[BASE + 7]);                              \
    auto r0 = __builtin_amdgcn_permlane32_swap(a0, b0, false, false); auto r1 = __builtin_amdgcn_permlane32_swap(a1, b1, false, false); \
    u32x4 w = {r0[0], r1[0], r0[1], r1[1]}; OUT = __builtin_bit_cast(bf16x8, w); } while (0)
  PK4(p0, 0, pa0); PK4(p0, 8, pa1); PK4(p1, 0, pa2); PK4(p1, 8, pa3);
#undef PK4
}
__device__ __forceinline__ void qkt(f32x16& p0, f32x16& p1, const char* Ks, const bf16x8* qr, int r32, int hi) {
  p0 = f32x16{}; p1 = f32x16{};
#pragma unroll
  for (int d0 = 0; d0 < 12; ++d0) { const int cb = (d0 * 16 + hi * 8) * 2;
    const bf16x8 b0 = *reinterpret_cast<const bf16x8*>(Ks + KSWZ(r32, cb));
    const bf16x8 b1 = *reinterpret_cast<const bf16x8*>(Ks + KSWZ(32 + r32, cb));
    p0 = __builtin_amdgcn_mfma_f32_32x32x16_bf16(b0, qr[d0], p0, 0, 0, 0);
    p1 = __builtin_amdgcn_mfma_f32_32x32x16_bf16(b1, qr[d0], p1, 0, 0, 0); }
}
__device__ __forceinline__ int v_st(int k, int c) { const int kk = (k & ~0xC) | ((k & 4) << 1) | ((k & 8) >> 1); return ((kk >> 3) * 4 + (c >> 5)) * 512 + ((kk & 7) * 32 + (c & 31)) * 2; }
__device__ __forceinline__ int v_rd_base(int lane) { return ((lane & 3) << 3) | (((lane >> 2) & 3) << 6) | (((lane >> 4) & 1) << 5) | (((lane >> 5) & 1) << 8); }
constexpr int v_rd_off(int d0, int ks, int half) { return d0 * 512 + ks * 4096 + half * 2048; }
template <int OFF> __device__ __forceinline__ s16x4 tr_read(int vb) {
  s16x4 r; asm volatile("ds_read_b64_tr_b16 %0, %1 offset:%2" : "=&v"(r) : "v"(vb), "i"(OFF) : "memory"); return r;
}
template <int D0> __device__ __forceinline__ void pv_one(f32x16& od, int vb, bf16x8 pa0, bf16x8 pa1, bf16x8 pa2, bf16x8 pa3) {
  const s16x4 l0 = tr_read<v_rd_off(D0, 0, 0)>(vb), h0 = tr_read<v_rd_off(D0, 0, 1)>(vb), l1 = tr_read<v_rd_off(D0, 1, 0)>(vb), h1 = tr_read<v_rd_off(D0, 1, 1)>(vb);
  const s16x4 l2 = tr_read<v_rd_off(D0, 2, 0)>(vb), h2 = tr_read<v_rd_off(D0, 2, 1)>(vb), l3 = tr_read<v_rd_off(D0, 3, 0)>(vb), h3 = tr_read<v_rd_off(D0, 3, 1)>(vb);
  asm volatile("s_waitcnt lgkmcnt(0)" ::: "memory"); SBAR();
#define PK(L, H) (bf16x8){L[0], L[1], L[2], L[3], H[0], H[1], H[2], H[3]}
  od = __builtin_amdgcn_mfma_f32_32x32x16_bf16(pa0, PK(l0, h0), od, 0, 0, 0);
  od = __builtin_amdgcn_mfma_f32_32x32x16_bf16(pa1, PK(l1, h1), od, 0, 0, 0);
  od = __builtin_amdgcn_mfma_f32_32x32x16_bf16(pa2, PK(l2, h2), od, 0, 0, 0);
  od = __builtin_amdgcn_mfma_f32_32x32x16_bf16(pa3, PK(l3, h3), od, 0, 0, 0);
#undef PK
}
__device__ __forceinline__ void pv_d0(f32x16* o, int vb, bf16x8 pa0, bf16x8 pa1, bf16x8 pa2, bf16x8 pa3) {
  pv_one<0>(o[0], vb, pa0, pa1, pa2, pa3); pv_one<1>(o[1], vb, pa0, pa1, pa2, pa3); pv_one<2>(o[2], vb, pa0, pa1, pa2, pa3); pv_one<3>(o[3], vb, pa0, pa1, pa2, pa3);
}
__device__ __forceinline__ void attn_unit(const bf16* __restrict__ Qb, const bf16* __restrict__ Kh, const bf16* __restrict__ Vh, bf16* __restrict__ Ob, int seq, char* lds) {
  const int tid = threadIdx.x, wid = tid >> 6, lane = tid & 63, r32 = lane & 31, hi = lane >> 5;
  char* V_lds = lds; char* K_lds = lds + 2 * SHM_V;
  float* wsp = (float*)(lds + 2 * SHM_V + 2 * SHM_K) + wid * 64; float* li_l = wsp; float* al_l = wsp + 32;
  float m_reg = -1e30f, l_reg = 0; f32x16 o[4] = {}; bf16x8 qr[12];
  const bf16* Qw = Qb + (long)(wid * QBLK + r32) * DQK + hi * 8;
#pragma unroll
  for (int d0 = 0; d0 < 12; ++d0) qr[d0] = *reinterpret_cast<const bf16x8*>(Qw + d0 * 16);
  const int sr = tid >> 4, sc = (tid & 15) * 8, vst0 = v_st(sr, sc), vst1 = v_st(32 + sr, sc);
  int krow[3], kch[3];
#pragma unroll
  for (int i = 0; i < 3; ++i) { const int q = tid + 512 * i; krow[i] = q / 24; kch[i] = q % 24; }
  const int vb0 = (int)(uintptr_t)V_lds + v_rd_base(lane);
  bf16x8 vs0, vs1, ks0, ks1, ks2;
#define SLOAD(k0) do { vs0 = *reinterpret_cast<const bf16x8*>(&Vh[(long)((k0) + sr) * DV + sc]); vs1 = *reinterpret_cast<const bf16x8*>(&Vh[(long)((k0) + 32 + sr) * DV + sc]); \
    ks0 = *reinterpret_cast<const bf16x8*>(&Kh[(long)((k0) + krow[0]) * DQK + kch[0] * 8]); ks1 = *reinterpret_cast<const bf16x8*>(&Kh[(long)((k0) + krow[1]) * DQK + kch[1] * 8]); \
    ks2 = *reinterpret_cast<const bf16x8*>(&Kh[(long)((k0) + krow[2]) * DQK + kch[2] * 8]); } while (0)
#define SWRITE(b) do { *(bf16x8*)(V_lds + (b) * SHM_V + vst0) = vs0; *(bf16x8*)(V_lds + (b) * SHM_V + vst1) = vs1; \
    *(bf16x8*)(K_lds + (b) * SHM_K + KSWZ(krow[0], kch[0] * 16)) = ks0; *(bf16x8*)(K_lds + (b) * SHM_K + KSWZ(krow[1], kch[1] * 16)) = ks1; \
    *(bf16x8*)(K_lds + (b) * SHM_K + KSWZ(krow[2], kch[2] * 16)) = ks2; } while (0)
#define SWAIT() asm volatile("s_waitcnt vmcnt(0)" ::: "memory")
#define RESC(a) do { if (__any((a) < 1.f)) { if (hi == 0) al_l[r32] = (a); asm volatile("s_waitcnt lgkmcnt(0)" ::: "memory"); \
    _Pragma("unroll") for (int d = 0; d < 4; ++d) _Pragma("unroll") for (int r = 0; r < 16; ++r) o[d][r] *= al_l[crow(r, hi)]; } } while (0)
  f32x16 p0, p1; float mn, al; bf16x8 pa0, pa1, pa2, pa3; const int NT = seq / KVBLK;
  SLOAD(0); SWAIT(); SWRITE(0); __syncthreads();
  for (int j = 0; j < NT; ++j) {
    const int buf = j & 1; const bool more = (j + 1 < NT);
    if (more) SLOAD((j + 1) * KVBLK);
    SBAR(); qkt(p0, p1, K_lds + buf * SHM_K, qr, r32, hi);
    partialSM(p0, p1, m_reg, mn, al);
    RESC(al);
    finishSM(p0, p1, al, l_reg, pa0, pa1, pa2, pa3); SBAR();
    pv_d0(o, vb0 + buf * SHM_V, pa0, pa1, pa2, pa3);
    if (more) { SWAIT(); SWRITE(buf ^ 1); }
    __syncthreads();
  }
  if (hi == 0) li_l[r32] = l_reg; asm volatile("s_waitcnt lgkmcnt(0)" ::: "memory");
  float rli[16];
#pragma unroll
  for (int r = 0; r < 16; ++r) rli[r] = __builtin_amdgcn_rcpf(li_l[crow(r, hi)]);
  bf16* Ow = Ob + (long)(wid * QBLK) * D;
#pragma unroll
  for (int r = 0; r < 16; ++r) { const int orow = crow(r, hi);
#pragma unroll
    for (int d0 = 0; d0 < 4; ++d0) Ow[(long)orow * D + d0 * 32 + r32] = (bf16)f2bf(o[d0][r] * rli[r]); }
#undef SLOAD
#undef SWRITE
#undef SWAIT
#undef RESC
}
#undef KSWZ
}

__device__ __forceinline__ void attn_phase(Frame& F, const bf16* QF, const bf16* KF, const bf16* VF, bf16* O, char* lds) {
    for (int ui = F.vcu; ui < 576; ui += F.G) {
        int bh, qrow0, seq; long orow0;
        if (ui < 512) { bh = ui >> 3; const int qb = ui & 7; qrow0 = CTXL + qb * 256; seq = KEYS; orow0 = (long)(bh >> 3) * SEQ + qb * 256; }
        else { bh = ui - 512; qrow0 = 0; seq = CTXL; orow0 = (long)TL + (long)(bh >> 3) * CTXL; }
        __syncthreads();
        att::attn_unit(QF + ((size_t)bh * KEYS + qrow0) * DQK, KF + (size_t)bh * KEYS * DQK, VF + (size_t)bh * KEYS * DV, O + (size_t)orow0 * D + (bh & 7) * DV, seq, lds);
    }
    __syncthreads();
}

#ifndef MK_ONE_LAUNCH
#define MK_ONE_LAUNCH 1
#endif
constexpr int NPHASES = 38;
struct Args { const float* in[39]; float* out; unsigned char* ws; int ph_lo, ph_hi; };

__global__ void __launch_bounds__(NTHREADS, 2) fwd(Args args) {
    extern __shared__ __attribute__((aligned(16))) unsigned char lds[];
    Frame F;
    F.lds = (LAS unsigned char*)lds; F.misc = F.lds + MISC_OFF;
    F.tid = threadIdx.x; F.lane = F.tid & 63; F.wave = __builtin_amdgcn_readfirstlane(F.tid >> 6);
    F.G = gridDim.x; { const int bx = blockIdx.x; F.vcu = (F.G % 8 == 0) ? (bx % 8) * (F.G / 8) + bx / 8 : bx; }
    F.ws = args.ws; F.ctl = (unsigned*)(args.ws + WS_CTL); F.in = args.in;
    unsigned char* ws = args.ws; const float* const* in = args.in;
    if (F.tid < 16) ((LAS unsigned*)F.misc)[F.tid] = 0u;
    __syncthreads();
    XcdBarrier bar; bar.bar = F.ctl + CW_BAR; bar.x = 0; bar.st = nullptr;
    const int lo = args.ph_lo, hi = args.ph_hi;
    if (hi - lo > 1) bar = xcd_barrier_post(F.ctl + CW_BAR, (volatile LAS unsigned*)(F.misc + MI_BAR));
#ifndef PH_MIN
#define PH_MIN 0
#endif
#ifndef PH_MAX
#define PH_MAX 1000
#endif
#define IN(k) ((k) >= PH_MIN && (k) <= PH_MAX && lo <= (k) && (k) < hi)
#define SEAM(k) do { if (IN(k) && IN((k) + 1)) xcd_barrier(bar); } while (0)

    float* MOD = (float*)(ws + WS_MOD); float* H = (float*)(ws + WS_H);
    bf16* NBf = (bf16*)(ws + WS_NB); bf16* UB = (bf16*)(ws + WS_UB); bf16* VT = (bf16*)(ws + WS_VT); bf16* ZB = (bf16*)(ws + WS_ZB);
    bf16* XH = (bf16*)(ws + WS_XH); float* SBf = (float*)(ws + WS_SB); bf16* ZL = (bf16*)(ws + WS_ZL); bf16* QR = (bf16*)(ws + WS_QR);
    bf16* QF = (bf16*)(ws + WS_QF); bf16* KF = (bf16*)(ws + WS_KF); bf16* VF = (bf16*)(ws + WS_VF); bf16* ACT = (bf16*)(ws + WS_ACT); bf16* YB = (bf16*)(ws + WS_YB);
    int* TOPE = (int*)(ws + WS_TOPE); float* TOPG = (float*)(ws + WS_TOPG); int* TOKSLOT = (int*)(ws + WS_TOKSLOT); int* SLOTTOK = (int*)(ws + WS_SLOTTOK); float* SLOTGATE = (float*)(ws + WS_SLOTGATE);
    float* VSSQ = (float*)(ws + WS_VSSQ); float* MLASSQ = (float*)(ws + WS_MLASSQ);
    LAS unsigned char* ring = F.lds;

    if (IN(0)) { p0_prologue(F); } SEAM(0);

#define MOE_BLOCK(L, PB, NR) \
    if (IN(PB)) { norm_phase<false, true>(F, NR, in[7] + (L) * 1024, MOD + (size_t)(L) * 9 * 6144, 3072, 4096, nullptr, nullptr, nullptr, H, NBf, \
                      (const float*)(ws + WS_WRT) + (size_t)(L) * 32768, in[32] + (L) * 32, TOPE, TOPG, F.ctl + CW_HIST + ((L) * 256 + F.vcu) * 32); } SEAM(PB); \
    if (IN((PB) + 1)) { dispatch_phase(F, NR, F.ctl + CW_HIST + (L) * 256 * 32, F.ctl + CW_MOE + (L) * 128, TOPE, TOPG, TOKSLOT, SLOTTOK, SLOTGATE); } SEAM((PB) + 1); \
    if (IN((PB) + 2)) { moe_tables(F, F.ctl + CW_MOE + (L) * 128); \
        MoeSched S{(const LAS int*)(F.misc + MI_TSTART), (const LAS int*)(F.misc + MI_ECNT), (const LAS int*)(F.misc + MI_ESTART), 8, F.G, (int)blockIdx.x}; \
        MoeUpOps O{(const char*)NBf, (const char*)(ws + WS_WGU) + (size_t)(L) * 32 * 2048 * 1024 * 2, SLOTTOK, 1024, 1024, 1024}; \
        EpiMoeUp E{ACT, in[34] + (size_t)(L) * 32 * 1024, in[36] + (size_t)(L) * 32 * 1024}; \
        pg::gemm_phase(ring, O, S, E); } SEAM((PB) + 2); \
    if (IN((PB) + 3)) { moe_tables(F, F.ctl + CW_MOE + (L) * 128); \
        MoeSched S{(const LAS int*)(F.misc + MI_TSTART), (const LAS int*)(F.misc + MI_ECNT), (const LAS int*)(F.misc + MI_ESTART), 4, F.G, (int)blockIdx.x}; \
        MoeDownOps O{(const char*)ACT, (const char*)(ws + WS_WD) + (size_t)(L) * 32 * 1024 * 1024 * 2, 1024, 1024, 1024}; \
        EpiMoeDown E{YB, in[38] + (size_t)(L) * 32 * 1024, SLOTGATE}; \
        pg::gemm_phase(ring, O, S, E); } SEAM((PB) + 3);

#define GMLP_BLOCK(L, SL, PB, NR) \
    if (IN((PB) + 1)) { \
        { DenseOps O{(const char*)NBf, (const char*)(ws + WS_WSGIN) + (size_t)(SL) * 2048 * 1024 * 2, 1024, 1024, 1024}; DenseSched S; S.init(NR, 1024, F.G, (int)blockIdx.x); EpiBf16Gelu E{UB, 1024}; pg::gemm_phase(ring, O, S, E); } \
        { DenseOps O{(const char*)(ws + WS_WSGIN) + ((size_t)(SL) * 2048 + 1024) * 1024 * 2, (const char*)NBf, 1024, 1024, 1024}; DenseSched S; S.init(1024, NR, F.G, (int)blockIdx.x); EpiVT E{VT, TT, VSSQ, TT}; pg::gemm_phase(ring, O, S, E); } \
    } SEAM((PB) + 1); \
    if (IN((PB) + 2)) { spatial_phase(F, (NR) / 128, in[10] + (size_t)(SL) * 8 * 128 * 128, in[11] + (size_t)(SL) * 8 * 128, in[9] + (size_t)(SL) * 1024, VT, VSSQ, UB, ZB); } SEAM((PB) + 2); \
    if (IN((PB) + 3)) { DenseOps O{(const char*)ZB, (const char*)(ws + WS_WSGOUT) + (size_t)(SL) * 1024 * 1024 * 2, 1024, 1024, 1024}; DenseSched S; S.init(NR, 1024, F.G, (int)blockIdx.x); \
        EpiResid E{H, MOD + (size_t)(L) * 9 * 6144, 2048}; pg::gemm_phase(ring, O, S, E); } SEAM((PB) + 3);

    if (IN(1)) { norm_phase<false, false>(F, TT, in[6] + 0 * 1024, MOD + (size_t)0 * 9 * 6144, 0, 1024, nullptr, nullptr, nullptr, H, NBf, nullptr, nullptr, nullptr, nullptr, nullptr); } SEAM(1);
    GMLP_BLOCK(0, 0, 1, TT)
    MOE_BLOCK(0, 5, TT)

    if (IN(9)) { norm_phase<true, false>(F, TT, in[6] + 1 * 1024, MOD + (size_t)1 * 9 * 6144, 0, 1024, MOD + (size_t)0 * 9 * 6144, YB, TOKSLOT, H, NBf, nullptr, nullptr, nullptr, nullptr, nullptr); } SEAM(9);
    if (IN(10)) { DenseOps O{(const char*)NBf, (const char*)(ws + WS_WSSMIN), 1024, 1024, 1024}; DenseSched S; S.init(TT, 1024, F.G, (int)blockIdx.x); EpiS5In E{XH}; pg::gemm_phase(ring, O, S, E); } SEAM(10);
    if (IN(11)) { S5Ops O{(const char*)XH, (const char*)(ws + WS_GT), 256, 512, 256}; S5Sched S{F.G, (int)blockIdx.x}; EpiS5State E{SBf}; pg::gemm_phase(ring, O, S, E); } SEAM(11);
    if (IN(12)) { s5_scan_phase(F, SBf, XH, (const float*)(ws + WS_A16)); } SEAM(12);
    if (IN(13)) { S5Ops O{(const char*)XH, (const char*)(ws + WS_TET), 512, 512, 512}; S5Sched S{F.G, (int)blockIdx.x}; EpiS5Out E{ZB}; pg::gemm_phase(ring, O, S, E); } SEAM(13);
    if (IN(14)) { DenseOps O{(const char*)ZB, (const char*)(ws + WS_WGLU), 1024, 1024, 1024}; DenseSched S; S.init(TT, 2048, F.G, (int)blockIdx.x); EpiGlu E{H, MOD + (size_t)1 * 9 * 6144, 2048}; pg::gemm_phase(ring, O, S, E); } SEAM(14);
    MOE_BLOCK(1, 15, TT)

    if (IN(19)) { norm_phase<true, false>(F, TT, in[6] + 2 * 1024, MOD + (size_t)2 * 9 * 6144, 0, 1024, MOD + (size_t)1 * 9 * 6144, YB, TOKSLOT, H, NBf, nullptr, nullptr, nullptr, nullptr, nullptr); } SEAM(19);
    if (IN(20)) { DenseOps O{(const char*)NBf, (const char*)(ws + WS_WMLAIN), 1024, 1024, 1024}; DenseSched S; S.init(TT, 768, F.G, (int)blockIdx.x); EpiMlaIn E{ZL, MLASSQ}; pg::gemm_phase(ring, O, S, E); } SEAM(20);
    if (IN(21)) {
        { DenseOps O{(const char*)ZL, (const char*)(ws + WS_WUQ), 384, 768, 384}; DenseSched S; S.init(TT, 1536, F.G, (int)blockIdx.x); EpiMlaUp<0> E{QR, nullptr, MLASSQ, 0, 12, 1.0f / 384.0f}; pg::gemm_phase(ring, O, S, E); }
        { DenseOps O{(const char*)(ZL + 384), (const char*)(ws + WS_WUKV), 256, 768, 256}; DenseSched S; S.init(TT, 2048, F.G, (int)blockIdx.x); EpiMlaUp<1> E{KF, VF, MLASSQ, 12, 8, 1.0f / 256.0f}; pg::gemm_phase(ring, O, S, E); }
    } SEAM(21);
    if (IN(22)) { qk_finalize_phase(F, QR, ZL, QF, KF, in[28], in[29]); } SEAM(22);
    if (IN(23)) { attn_phase(F, QF, KF, VF, ZB, (char*)lds); } SEAM(23);
    if (IN(24)) { DenseOps O{(const char*)ZB, (const char*)(ws + WS_WMLAOUT), 1024, 1024, 1024}; DenseSched S; S.init(TT, 1024, F.G, (int)blockIdx.x); EpiResid E{H, MOD + (size_t)2 * 9 * 6144, 2048}; pg::gemm_phase(ring, O, S, E); } SEAM(24);
    MOE_BLOCK(2, 25, TT)

    if (IN(29)) { norm_phase<true, false>(F, TL, in[6] + 3 * 1024, MOD + (size_t)3 * 9 * 6144, 0, 1024, MOD + (size_t)2 * 9 * 6144, YB, TOKSLOT, H, NBf, nullptr, nullptr, nullptr, nullptr, nullptr); } SEAM(29);
    GMLP_BLOCK(3, 1, 29, TL)
    MOE_BLOCK(3, 33, TL)

    if (IN(37)) { final_phase(F, H, MOD + (size_t)3 * 9 * 6144, YB, TOKSLOT, args.out); }
#undef IN
#undef SEAM
}

extern "C" void kernel_launch(void* const* d_in, const int* in_sizes, int n_in, void* d_out, int out_size, void* d_ws, size_t ws_size, hipStream_t stream) {
    static int grid = 0;
    if (grid == 0) {
        if (n_in != 39 || out_size != TL * D || ws_size < WS_END) { fprintf(stderr, "kernel_launch: built for 39 inputs, out %d floats, >= %zu bytes of workspace; got n_in %d, out %d, ws %zu; nothing launched\n", TL * D, (size_t)WS_END, n_in, out_size, ws_size); grid = -1; return; }
        int dev = 0, cus = 0, per_cu = 0;
        if (hipGetDevice(&dev) != hipSuccess || hipDeviceGetAttribute(&cus, hipDeviceAttributeMultiprocessorCount, dev) != hipSuccess) { fprintf(stderr, "kernel_launch: device query failed\n"); grid = -1; return; }
        if (hipFuncSetAttribute((const void*)fwd, hipFuncAttributeMaxDynamicSharedMemorySize, LDS_BYTES) != hipSuccess) { fprintf(stderr, "kernel_launch: hipFuncSetAttribute failed\n"); grid = -1; return; }
        if (hipOccupancyMaxActiveBlocksPerMultiprocessor(&per_cu, (const void*)fwd, NTHREADS, LDS_BYTES) != hipSuccess || per_cu < 1) fprintf(stderr, "kernel_launch: note: occupancy query reports %d workgroups per CU\n", per_cu);
        (void)hipGetLastError();
        grid = cus;
        if (grid != 256) fprintf(stderr, "kernel_launch: warning: %d CUs; the row-to-workgroup deal assumes 256\n", grid);
    }
    if (grid < 0) return;
    if (hipMemsetAsync((char*)d_ws + WS_CTL, 0, CTL_ZERO_BYTES, stream) != hipSuccess) { fprintf(stderr, "kernel_launch: memset failed\n"); return; }
    Args a{};
    for (int i = 0; i < 39; ++i) a.in[i] = (const float*)d_in[i];
    a.out = (float*)d_out; a.ws = (unsigned char*)d_ws;
#if MK_ONE_LAUNCH
    a.ph_lo = 0; a.ph_hi = NPHASES;
    hipLaunchKernelGGL(fwd, dim3(grid), dim3(NTHREADS), LDS_BYTES, stream, a);
#else
    for (int p = 0; p < NPHASES; ++p) { a.ph_lo = p; a.ph_hi = p + 1; hipLaunchKernelGGL(fwd, dim3(grid), dim3(NTHREADS), LDS_BYTES, stream, a); }
#endif
    const hipError_t le = hipPeekAtLastError();
    if (le != hipSuccess) fprintf(stderr, "kernel_launch: launch failed: %s\n", hipGetErrorName(le));
}
```
